# Optimizing an MI355X kernel written in HIP

```python
import jax, jax.numpy as jnp
from jax import lax
import numpy as np

D_MODEL = 2048
BATCH = 1
SEQ = 8192
DEPTH = 1

D_MIX = D_MODEL
D_HGRN = D_MIX // 2
D_GLA = D_MIX - D_HGRN
HGRN_DK = 128
HGRN_HEADS = D_HGRN // HGRN_DK
HGRN_DV = D_HGRN // HGRN_HEADS
GLA_HEADS = 4
GLA_DK_TOTAL = D_GLA // 2
GLA_DK = GLA_DK_TOTAL // GLA_HEADS
GLA_DV = D_GLA // GLA_HEADS
GLA_GATE_RANK = 16
GLA_GATE_TAU = 16.0
PLE_DIM = 256
CHUNK = 64
EPS = 1e-6

IN_SPLITS = [D_HGRN, D_HGRN, D_HGRN, D_HGRN,
             GLA_DK_TOTAL, GLA_DK_TOTAL, D_GLA, D_GLA,
             GLA_GATE_RANK]
D_IN = sum(IN_SPLITS)

kernel_name = "hgrn2_gla_parallel_heads_ple"


def rms_norm(x, w):
    xf = x.astype(jnp.float32)
    y = xf * lax.rsqrt(jnp.mean(xf * xf, axis=-1, keepdims=True) + EPS)
    return (y * w.astype(jnp.float32)).astype(x.dtype)


def chunk_gated_linear_attention(q, k, v, log_g, scale):
    B, T, H, dk = q.shape
    dv = v.shape[-1]
    n = T // CHUNK

    def to_chunks(a):
        a = a.astype(jnp.float32).reshape(B, n, CHUNK, H, a.shape[-1])
        return jnp.transpose(a, (1, 0, 3, 2, 4))

    qc, kc, vc, gc = to_chunks(q * scale), to_chunks(k), to_chunks(v), to_chunks(log_g)
    causal = jnp.tril(jnp.ones((CHUNK, CHUNK), dtype=bool))[:, :, None]

    def step(S, inp):
        q_c, k_c, v_c, g_c = inp
        b = jnp.cumsum(g_c, axis=2)
        diff = b[:, :, :, None, :] - b[:, :, None, :, :]
        decay = jnp.where(causal, jnp.exp(jnp.where(causal, diff, 0.0)), 0.0)
        attn = jnp.einsum('bhik,bhjk,bhijk->bhij', q_c, k_c, decay)
        o = (jnp.einsum('bhij,bhjv->bhiv', attn, v_c)
             + jnp.einsum('bhik,bhkv->bhiv', q_c * jnp.exp(b), S))
        b_last = b[:, :, -1:, :]
        S = (jnp.exp(b_last[:, :, 0, :])[..., None] * S
             + jnp.einsum('bhjk,bhjv->bhkv', k_c * jnp.exp(b_last - b), v_c))
        return S, o

    S0 = jnp.zeros((B, H, dk, dv), jnp.float32)
    _, o = lax.scan(step, S0, (qc, kc, vc, gc))
    return jnp.transpose(o, (1, 0, 3, 2, 4)).reshape(B, T, H, dv)


def head_readout(o, norm_w, gate, n_heads, dv, dtype):
    B, T = o.shape[:2]
    o = rms_norm(o, norm_w.reshape(n_heads, dv))
    g = jax.nn.silu(gate.astype(jnp.float32)).reshape(B, T, n_heads, dv)
    return (o * g).reshape(B, T, n_heads * dv).astype(dtype)


def setup_inputs(seed: int = 0) -> dict:
    key = jax.random.key(seed)
    ks = jax.random.split(key, 16)
    f32 = jnp.float32
    nrm = lambda k, shape, s: (jax.random.normal(k, shape, f32) * s)
    gain = lambda k, shape: 1.0 + 0.02 * jax.random.normal(k, shape, f32)
    return {
        "x": jax.random.normal(ks[0], (BATCH, SEQ, D_MODEL), f32),
        "p": jax.random.normal(ks[1], (DEPTH, BATCH, SEQ, PLE_DIM), f32),
        "norm_mix_w": gain(ks[2], (DEPTH, D_MODEL)),
        "w_in": nrm(ks[3], (DEPTH, D_MODEL, D_IN), D_MODEL ** -0.5),
        "hgrn_lb": nrm(ks[4], (DEPTH + 1, D_HGRN), 0.1),
        "gla_gate_w2": nrm(ks[5], (DEPTH, GLA_GATE_RANK, GLA_DK_TOTAL), GLA_GATE_RANK ** -0.5),
        "gla_gate_b": nrm(ks[6], (DEPTH, GLA_DK_TOTAL), 0.01),
        "hgrn_norm_w": gain(ks[7], (DEPTH, D_HGRN)),
        "gla_norm_w": gain(ks[8], (DEPTH, D_GLA)),
        "w_out": nrm(ks[9], (DEPTH, D_MIX, D_MODEL), D_MIX ** -0.5),
        "ple_proj": nrm(ks[10], (DEPTH, PLE_DIM, D_MODEL), PLE_DIM ** -0.5),
        "ple_norm_w": gain(ks[11], (DEPTH, D_MODEL)),
        "ple_gate_norm_w": gain(ks[12], (DEPTH, D_MODEL)),
        "ple_gate_w": nrm(ks[13], (DEPTH, D_MODEL, D_MODEL), D_MODEL ** -0.5),
        "ple_gate_b": nrm(ks[14], (DEPTH, D_MODEL), 0.01),
        "final_norm_w": gain(ks[15], (D_MODEL,)),
    }


def reference(x, p, norm_mix_w, w_in, hgrn_lb, gla_gate_w2, gla_gate_b, hgrn_norm_w,
              gla_norm_w, w_out, ple_proj, ple_norm_w, ple_gate_norm_w, ple_gate_w,
              ple_gate_b, final_norm_w):
    B, T, _ = x.shape
    dtype = x.dtype
    lb_all = jnp.cumsum(jax.nn.softmax(hgrn_lb.astype(jnp.float32), axis=0), axis=0)
    offsets = np.cumsum(IN_SPLITS)[:-1].tolist()
    h = x
    for i in range(DEPTH):
        u = rms_norm(h, norm_mix_w[i])
        proj = u @ w_in[i]
        hq, hf, hi, hz, gq, gk, gv, gz, glr = jnp.split(proj, offsets, axis=-1)

        lb = lb_all[i]
        f = lb + (1.0 - lb) * jax.nn.sigmoid(hf.astype(jnp.float32))
        hshape = (B, T, HGRN_HEADS, HGRN_DK)
        o_h = chunk_gated_linear_attention(
            jax.nn.silu(hq.astype(jnp.float32)).reshape(hshape),
            (1.0 - f).reshape(hshape),
            hi.reshape(B, T, HGRN_HEADS, HGRN_DV),
            jnp.log(f).reshape(hshape),
            HGRN_DK ** -0.5)
        y_h = head_readout(o_h, hgrn_norm_w[i], hz, HGRN_HEADS, HGRN_DV, dtype)

        gate_logit = glr.astype(jnp.float32) @ gla_gate_w2[i].astype(jnp.float32) + gla_gate_b[i]
        log_a = jax.nn.log_sigmoid(gate_logit) / GLA_GATE_TAU
        gshape = (B, T, GLA_HEADS, GLA_DK)
        o_g = chunk_gated_linear_attention(
            gq.reshape(gshape), gk.reshape(gshape),
            gv.reshape(B, T, GLA_HEADS, GLA_DV), log_a.reshape(gshape),
            GLA_DK ** -0.5)
        y_g = head_readout(o_g, gla_norm_w[i], gz, GLA_HEADS, GLA_DV, dtype)

        y = jnp.concatenate([y_h, y_g], axis=-1) @ w_out[i]
        h = h + y.astype(dtype)

        e = rms_norm(p[i] @ ple_proj[i], ple_norm_w[i])
        gate = jax.nn.sigmoid(rms_norm(h, ple_gate_norm_w[i]) @ ple_gate_w[i] + ple_gate_b[i])
        h = h + (gate * e).astype(dtype)
    return rms_norm(h, final_norm_w)
```

```cpp
#include <hip/hip_runtime.h>
#include <hip/hip_cooperative_groups.h>
#include <cstdio>
namespace cg = cooperative_groups;

#ifndef MK_MULTI
#define MK_MULTI 0
#endif

#define LAS __attribute__((address_space(3)))
typedef unsigned short bf16_t;
typedef short bf16x8 __attribute__((ext_vector_type(8)));
typedef float f32x4 __attribute__((ext_vector_type(4)));
typedef unsigned u32x4 __attribute__((ext_vector_type(4)));
typedef unsigned u32x2 __attribute__((ext_vector_type(2)));

constexpr int T = 8192, D = 2048, DIN = 7184, NPAD = 7424, PS = 7168  ;
constexpr int NCHUNK = 128, NITEM = NCHUNK * 12, SELEM = 262144;
constexpr float EPS = 1e-6f;
constexpr float QSCALE = 0.08838834764831845f;

constexpr size_t WS_U = 0;
constexpr size_t WS_WINT = WS_U + (size_t)T * D * 2;
constexpr size_t WS_PB = WS_WINT + (size_t)NPAD * D * 2;
constexpr size_t WS_WPT = WS_PB + (size_t)T * 256 * 2;
constexpr size_t WS_WOUTT = WS_WPT + (size_t)D * 256 * 2;
constexpr size_t WS_WGT = WS_WOUTT + (size_t)D * D * 2;
constexpr size_t WS_PROJ = WS_WGT + (size_t)D * D * 2;
constexpr size_t WS_HG = WS_PROJ + (size_t)T * PS * 2;
constexpr size_t WS_GLR = WS_HG + (size_t)T * 1024 * 4;
constexpr size_t WS_DEC = WS_GLR + (size_t)T * 16 * 4;
constexpr size_t WS_HSS = WS_DEC + (size_t)NCHUNK * 12 * 128 * 4;
constexpr size_t WS_ESS = WS_HSS + (size_t)T * 32 * 4;
constexpr size_t WS_H2SS = WS_ESS + (size_t)T * 32 * 4;
constexpr size_t WS_END = WS_H2SS + (size_t)T * 32 * 4;
constexpr size_t WS_BAR = (WS_END + 255) & ~(size_t)255;
constexpr size_t WS_CNT = WS_BAR + 16384;
constexpr size_t WS_XS = WS_CNT + 8192;
constexpr int LDS_XB = 139264;
constexpr int LDS_BYTES = 140 * 1024;

struct Args { const float* in[16]; float* out; unsigned char* ws; int ph_lo, ph_hi; };
enum { I_X = 0, I_P, I_NMW, I_WIN, I_HLB, I_GW2, I_GGB, I_HNW, I_GNW, I_WOUT, I_PPROJ, I_PNW, I_PGNW, I_PGW, I_PGB, I_FNW };

typedef __bf16 bf16v2 __attribute__((ext_vector_type(2)));
typedef float f32x2 __attribute__((ext_vector_type(2)));
__device__ __forceinline__ unsigned cvt_pk_bf16(float lo, float hi) { const f32x2 v = {lo, hi}; const bf16v2 b = __builtin_convertvector(v, bf16v2); return __builtin_bit_cast(unsigned, b); }
__device__ __forceinline__ bf16_t f2bf(float f) { return (bf16_t)(cvt_pk_bf16(f, 0.f) & 0xffffu); }
__device__ __forceinline__ float bf2f(unsigned b) { return __uint_as_float(b << 16); }
__device__ __forceinline__ float bflo(unsigned w) { return __uint_as_float(w << 16); }
__device__ __forceinline__ float bfhi(unsigned w) { return __uint_as_float(w & 0xffff0000u); }
__device__ __forceinline__ float wave_sum(float v) {
#pragma unroll
    for (int m = 32; m >= 1; m >>= 1) v += __shfl_xor(v, m);
    return v;
}
__device__ __forceinline__ float sigmoidf_(float x) { return __builtin_amdgcn_rcpf(1.0f + __expf(-x)); }

constexpr int BM = 256, BK = 64, HALF = 128, HTB = HALF * BK * 2, STAGE_BYTES = 8 * HTB, NXCD = 8, WGM = 8;
__host__ __device__ __forceinline__ int lds_byte(int r, int c) { const int st = (r >> 4) * 2 + (c >> 5), rr = r & 15, cc = c & 31, ob = rr * 64 + cc * 2; return st * 1024 + (ob ^ (((ob >> 9) & 1) << 5)); }
__host__ __device__ __forceinline__ void stage_rc(int b, int& R, int& C) { const int st = b / 1024, sb = b % 1024, swz = sb ^ (((sb >> 9) & 1) << 5); R = (st >> 1) * 16 + swz / 64; C = (st & 1) * 32 + (swz % 64) / 2; }
__host__ __device__ __forceinline__ int perm32(int rho) { const int n = rho >> 4, i = rho & 15; return 8 * (i >> 2) + 4 * n + (i & 3); }
struct Unit { int pm, pn; };
struct Gemm { const bf16_t* A; const bf16_t* Bt; int M, N, K; };
struct StaticOrder {
    int nM, nN, nwg, G, c, mix;
    __host__ __device__ void init(int M, int N, int G_, int c_, int mix_ = 0) { nM = M / BM; nN = N / BM; nwg = nM * nN; G = G_; c = c_; mix = mix_; }
    __host__ __device__ bool next(int i, Unit& u) const {
        const long L = (long)i * G + c; if (L >= nwg) return false;
        int wgid = (int)L; { const int q = nwg / NXCD, r = nwg % NXCD, xcd = wgid % NXCD, off = wgid / NXCD; wgid = (xcd < r ? xcd * (q + 1) : r * (q + 1) + (xcd - r) * q) + off; }
        const int nig = WGM * nN, gid = wgid / nig, fm = gid * WGM, gsz = (nM - fm) < WGM ? (nM - fm) : WGM;
        u.pm = fm + ((wgid % nig) % gsz); u.pn = (wgid % nig) / gsz;
        if (mix) {
            const int sidx = u.pn;
            u.pn = sidx < 8 ? sidx + 4 : sidx < 12 ? sidx - 8 : sidx < 15 ? sidx : sidx < 21 ? sidx + 3 : sidx == 21 ? 28 : sidx == 22 ? 15 : sidx < 25 ? sidx - 7 : sidx - 1;
        }
        return true;
    }
};

template <class Epi>
__device__ __forceinline__ void gemm_phase(LAS unsigned char* lds, const Gemm g, const StaticOrder& S, const Epi& E) {
    int tid = threadIdx.x; asm volatile("" : "+v"(tid));
    const int wid = __builtin_amdgcn_readfirstlane(tid >> 6), lane = tid & 63, wr = wid >> 2, wc = wid & 3, fr = lane & 15, fq = lane >> 4;
    const int K = g.K, nt = K / BK;
    unsigned voffA[2], voffB[2];
#pragma unroll
    for (int i = 0; i < 2; ++i) { int R, C; stage_rc(tid * 16 + i * 8192, R, C); const int Rb = Epi::PERM ? ((R & ~31) + perm32(R & 31)) : R;
        voffA[i] = (unsigned)(R * K + C) * 2u; voffB[i] = (unsigned)(Rb * K + C) * 2u; }
    const size_t kstep = (size_t)(BK * 2);
    const size_t hstep = (size_t)HALF * K * 2;
    const size_t tstep = 2 * hstep;
    const unsigned ldsw = (unsigned)wid * 1024u;
    const int aoff = lds_byte(wr * 64 + fr, fq * 8), boff = lds_byte(wc * 32 + fr, fq * 8);
#define PG8_SA(b, h) (((b) * 2 + (h)) * HTB)
#define PG8_SB(b, h) ((4 + (b) * 2 + (h)) * HTB)
#define PG8_STAGE(bufoff, gbase, voff) do { _Pragma("unroll") for (int _i = 0; _i < 2; ++_i) \
        __builtin_amdgcn_global_load_lds((const unsigned*)((const char*)(gbase) + (voff)[_i]), (LAS unsigned*)(lds + (bufoff) + ldsw + _i * 8192), 16, 0, 0); } while (0)
#define PG8_LDA(dst, b, h) do { _Pragma("unroll") for (int m = 0; m < 4; ++m) _Pragma("unroll") for (int k = 0; k < 2; ++k) dst[m][k] = *(const LAS bf16x8*)(lds + PG8_SA(b, h) + aoff + m * 2048 + k * 1024); } while (0)
#define PG8_LDB(dst, b, h) do { _Pragma("unroll") for (int n = 0; n < 2; ++n) _Pragma("unroll") for (int k = 0; k < 2; ++k) dst[n][k] = *(const LAS bf16x8*)(lds + PG8_SB(b, h) + boff + n * 2048 + k * 1024); } while (0)
#define PG8_MMA(ai, bj, At, Bt) do { __builtin_amdgcn_s_setprio(1); _Pragma("unroll") for (int m = 0; m < 4; ++m) _Pragma("unroll") for (int n = 0; n < 2; ++n) _Pragma("unroll") for (int k = 0; k < 2; ++k) \
        acc[ai][bj][m][n] = __builtin_amdgcn_mfma_f32_16x16x32_bf16(Bt[n][k], At[m][k], acc[ai][bj][m][n], 0, 0, 0); __builtin_amdgcn_s_setprio(0); } while (0)
#define PG8_WAIT_V(n) asm volatile("s_waitcnt vmcnt(" #n ")" ::: "memory")
#define PG8_WAIT_L(n) asm volatile("s_waitcnt lgkmcnt(" #n ")" ::: "memory")
#define PG8_BAR __builtin_amdgcn_s_barrier()
#define PG8_SCHED __builtin_amdgcn_sched_barrier(0)
    Unit cur, nxt; int ui = 0;
    if (!S.next(0, cur)) return;
    f32x4 acc[2][2][4][2];
#pragma unroll
    for (int a = 0; a < 2; ++a)
#pragma unroll
        for (int b = 0; b < 2; ++b)
#pragma unroll
            for (int m = 0; m < 4; ++m)
#pragma unroll
                for (int n = 0; n < 2; ++n) acc[a][b][m][n] = (f32x4){0.f, 0.f, 0.f, 0.f};
    bf16x8 At[4][2], B0[2][2], B1[2][2];
    const char* cA = (const char*)g.A + (size_t)cur.pm * tstep; const char* cB = (const char*)g.Bt + (size_t)cur.pn * tstep;
    PG8_STAGE(PG8_SB(0, 0), cB, voffB); PG8_STAGE(PG8_SA(0, 0), cA, voffA); PG8_STAGE(PG8_SB(0, 1), cB + hstep, voffB); PG8_STAGE(PG8_SA(0, 1), cA + hstep, voffA);
    if (wr == 1) PG8_BAR;
    PG8_WAIT_V(4); PG8_BAR;
    PG8_STAGE(PG8_SB(1, 0), cB + kstep, voffB); PG8_STAGE(PG8_SA(1, 0), cA + kstep, voffA); PG8_STAGE(PG8_SB(1, 1), cB + hstep + kstep, voffB);
    PG8_WAIT_V(6); PG8_BAR;
    for (;;) {
        const bool has_next = S.next(ui + 1, nxt);
        const char* nA = has_next ? (const char*)g.A + (size_t)nxt.pm * tstep : cA; const char* nB = has_next ? (const char*)g.Bt + (size_t)nxt.pn * tstep : cB;
#pragma unroll 1
        for (int t = 0; t < nt; t += 2) {
            const bool last = (t == nt - 2);
            const char* a1 = cA + (size_t)(t + 1) * kstep;
            const char* a2 = last ? nA : cA + (size_t)(t + 2) * kstep; const char* b2 = last ? nB : cB + (size_t)(t + 2) * kstep;
            const char* a3 = a2 + kstep; const char* b3 = b2 + kstep;
            PG8_LDB(B0, 0, 0); PG8_SCHED; PG8_LDA(At, 0, 0); PG8_STAGE(PG8_SA(1, 1), a1 + hstep, voffA);
            PG8_WAIT_L(8); PG8_BAR; PG8_WAIT_L(0); PG8_MMA(0, 0, At, B0); PG8_BAR; PG8_SCHED;
            PG8_LDB(B1, 0, 1); PG8_STAGE(PG8_SB(0, 0), b2, voffB);
            PG8_BAR; PG8_WAIT_L(0); PG8_MMA(0, 1, At, B1); PG8_BAR;
            PG8_LDA(At, 0, 1); PG8_STAGE(PG8_SA(0, 0), a2, voffA);
            PG8_BAR; PG8_WAIT_L(0); PG8_MMA(1, 0, At, B0); PG8_BAR; PG8_SCHED;
            PG8_STAGE(PG8_SB(0, 1), b2 + hstep, voffB);
            PG8_WAIT_V(6); PG8_BAR; PG8_MMA(1, 1, At, B1); PG8_BAR;
            PG8_LDB(B0, 1, 0); PG8_SCHED; PG8_LDA(At, 1, 0); PG8_STAGE(PG8_SA(0, 1), a2 + hstep, voffA);
            PG8_WAIT_L(8); PG8_BAR; PG8_WAIT_L(0); PG8_MMA(0, 0, At, B0); PG8_BAR; PG8_SCHED;
            PG8_LDB(B1, 1, 1); PG8_STAGE(PG8_SB(1, 0), b3, voffB);
            PG8_BAR; PG8_WAIT_L(0); PG8_MMA(0, 1, At, B1); PG8_BAR;
            PG8_LDA(At, 1, 1); PG8_STAGE(PG8_SA(1, 0), a3, voffA);
            PG8_BAR; PG8_WAIT_L(0); PG8_MMA(1, 0, At, B0); PG8_BAR; PG8_SCHED;
            PG8_STAGE(PG8_SB(1, 1), b3 + hstep, voffB);
            PG8_WAIT_V(6); PG8_BAR; PG8_MMA(1, 1, At, B1); PG8_BAR;
        }
        if constexpr (!Epi::AFTER_DRAIN) E(acc, cur, wr, wc, fr, fq);
        if (!has_next) break;
#pragma unroll
        for (int a = 0; a < 2; ++a)
#pragma unroll
            for (int b = 0; b < 2; ++b)
#pragma unroll
                for (int m = 0; m < 4; ++m)
#pragma unroll
                    for (int n = 0; n < 2; ++n) acc[a][b][m][n] = (f32x4){0.f, 0.f, 0.f, 0.f};
        cur = nxt; cA = nA; cB = nB; ++ui;
    }
    PG8_WAIT_V(0);
    if (wr == 0) PG8_BAR;
    PG8_BAR;
    if constexpr (Epi::AFTER_DRAIN) E.fused(acc, cur, wr, wc, fr, fq, lds);
#undef PG8_SA
#undef PG8_SB
#undef PG8_STAGE
#undef PG8_LDA
#undef PG8_LDB
#undef PG8_MMA
#undef PG8_WAIT_V
#undef PG8_WAIT_L
#undef PG8_BAR
#undef PG8_SCHED
}

struct Epi1 {
    static constexpr bool PERM = true, AFTER_DRAIN = false;
    bf16_t* proj; float* hg; float* glr; const float* hlb;
    __device__ __forceinline__ void operator()(const f32x4 (&acc)[2][2][4][2], const Unit& u, int wr, int wc, int fr, int fq) const {
        asm volatile("" : "+v"(fr), "+v"(fq));
        const int row0 = u.pm * BM + wr * 64 + fr, col0 = u.pn * BM + wc * 32 + 8 * fq, pn = u.pn;
        if (pn >= 4 && pn < 8) {
#pragma unroll
            for (int bj = 0; bj < 2; ++bj) {
                const int c = col0 + bj * HALF - 1024;
                float lb[8];
                { const f32x4 a0 = *(const f32x4*)(hlb + c), a1 = *(const f32x4*)(hlb + c + 4), b0 = *(const f32x4*)(hlb + 1024 + c), b1 = *(const f32x4*)(hlb + 1024 + c + 4);
#pragma unroll
                  for (int j = 0; j < 4; ++j) { lb[j] = __builtin_amdgcn_rcpf(1.0f + __expf(b0[j] - a0[j])); lb[4 + j] = __builtin_amdgcn_rcpf(1.0f + __expf(b1[j] - a1[j])); } }
#pragma unroll
                for (int ai = 0; ai < 2; ++ai)
#pragma unroll
                    for (int m = 0; m < 4; ++m) {
                        const size_t r = (size_t)(row0 + ai * HALF + m * 16);
                        f32x4 o0, o1;
#pragma unroll
                        for (int j = 0; j < 4; ++j) {
                            const float s0 = sigmoidf_(acc[ai][bj][m][0][j]), s1 = sigmoidf_(acc[ai][bj][m][1][j]);
                            o0[j] = lb[j] + (1.0f - lb[j]) * s0; o1[j] = lb[4 + j] + (1.0f - lb[4 + j]) * s1;
                        }
                        *(f32x4*)(hg + r * 1024 + c) = o0; *(f32x4*)(hg + r * 1024 + c + 4) = o1;
                    }
            }
        } else if (pn == 28) {
            if (wc == 0 && fq < 2) {
#pragma unroll
                for (int ai = 0; ai < 2; ++ai)
#pragma unroll
                    for (int m = 0; m < 4; ++m) {
                        const size_t r = (size_t)(row0 + ai * HALF + m * 16);
                        *(f32x4*)(glr + r * 16 + 8 * fq) = acc[ai][0][m][0]; *(f32x4*)(glr + r * 16 + 8 * fq + 4) = acc[ai][0][m][1];
                    }
            }
        } else {
            const bool do_silu = (pn < 4) || (pn >= 12 && pn < 16) || (pn >= 24);
            const float mul = (pn < 4 || pn == 16 || pn == 17) ? QSCALE : 1.0f;
#pragma unroll
            for (int ai = 0; ai < 2; ++ai)
#pragma unroll
                for (int m = 0; m < 4; ++m) {
                    bf16_t* rowp = proj + (size_t)(row0 + ai * HALF + m * 16) * PS + col0;
#pragma unroll
                    for (int bj = 0; bj < 2; ++bj) {
                        f32x4 v0 = acc[ai][bj][m][0], v1 = acc[ai][bj][m][1];
                        if (do_silu) {
#pragma unroll
                            for (int j = 0; j < 4; ++j) { v0[j] = v0[j] * sigmoidf_(v0[j]); v1[j] = v1[j] * sigmoidf_(v1[j]); }
                        }
                        v0 *= mul; v1 *= mul;
                        u32x4 w; w.x = cvt_pk_bf16(v0[0], v0[1]); w.y = cvt_pk_bf16(v0[2], v0[3]); w.z = cvt_pk_bf16(v1[0], v1[1]); w.w = cvt_pk_bf16(v1[2], v1[3]);
                        *(u32x4*)(rowp + bj * HALF) = w;
                    }
                }
        }
    }
};

struct Epi2 {
    static constexpr bool PERM = true, AFTER_DRAIN = false;
    const float* x; bf16_t* hb; float* hss;
    __device__ __forceinline__ void operator()(const f32x4 (&acc)[2][2][4][2], const Unit& u, int wr, int wc, int fr, int fq) const {
        asm volatile("" : "+v"(fr), "+v"(fq));
        const int row0 = u.pm * BM + wr * 64 + fr, col0 = u.pn * BM + wc * 32 + 8 * fq;
#pragma unroll
        for (int ai = 0; ai < 2; ++ai)
#pragma unroll
            for (int m = 0; m < 4; ++m) {
                const size_t r = (size_t)(row0 + ai * HALF + m * 16);
                float s = 0.f;
#pragma unroll
                for (int bj = 0; bj < 2; ++bj) {
                    const int c = col0 + bj * HALF;
                    const size_t o = r * D + c;
                    const f32x4 h0 = *(const f32x4*)(x + o) + acc[ai][bj][m][0], h1 = *(const f32x4*)(x + o + 4) + acc[ai][bj][m][1];
#pragma unroll
                    for (int j = 0; j < 4; ++j) s += h0[j] * h0[j] + h1[j] * h1[j];
                    u32x4 w; w.x = cvt_pk_bf16(h0[0], h0[1]); w.y = cvt_pk_bf16(h0[2], h0[3]); w.z = cvt_pk_bf16(h1[0], h1[1]); w.w = cvt_pk_bf16(h1[2], h1[3]);
                    *(u32x4*)(hb + o) = w;
                }
                s += __shfl_xor(s, 16); s += __shfl_xor(s, 32);
                if (fq == 0) hss[r * 32 + u.pn * 4 + wc] = s;
            }
    }
};

struct Epi3 {
    static constexpr bool PERM = true, AFTER_DRAIN = false;
    bf16_t* e; float* ess;
    __device__ __forceinline__ void operator()(const f32x4 (&acc)[2][2][4][2], const Unit& u, int wr, int wc, int fr, int fq) const {
        asm volatile("" : "+v"(fr), "+v"(fq));
        const int row0 = u.pm * BM + wr * 64 + fr, col0 = u.pn * BM + wc * 32 + 8 * fq;
#pragma unroll
        for (int ai = 0; ai < 2; ++ai)
#pragma unroll
            for (int m = 0; m < 4; ++m) {
                const size_t r = (size_t)(row0 + ai * HALF + m * 16);
                float s = 0.f;
#pragma unroll
                for (int bj = 0; bj < 2; ++bj) {
                    const f32x4 v0 = acc[ai][bj][m][0], v1 = acc[ai][bj][m][1];
#pragma unroll
                    for (int j = 0; j < 4; ++j) s += v0[j] * v0[j] + v1[j] * v1[j];
                    u32x4 w; w.x = cvt_pk_bf16(v0[0], v0[1]); w.y = cvt_pk_bf16(v0[2], v0[3]); w.z = cvt_pk_bf16(v1[0], v1[1]); w.w = cvt_pk_bf16(v1[2], v1[3]);
                    *(u32x4*)(e + r * D + col0 + bj * HALF) = w;
                }
                s += __shfl_xor(s, 16); s += __shfl_xor(s, 32);
                if (fq == 0) ess[r * 32 + u.pn * 4 + wc] = s;
                __builtin_amdgcn_sched_barrier(0);
            }
    }
};

struct Epi4 {
    static constexpr bool PERM = true, AFTER_DRAIN = false;
    const bf16_t* e; const float* gb; const float* pnw; const bf16_t* hbf; float* h; float* h2ss; const LAS float* rsT; StaticOrder S;
    __device__ __forceinline__ void operator()(const f32x4 (&acc)[2][2][4][2], const Unit& u, int wr, int wc, int fr, int fq) const {
        asm volatile("" : "+v"(fr), "+v"(fq));
        const int row0 = u.pm * BM + wr * 64 + fr, col0 = u.pn * BM + wc * 32 + 8 * fq;
        int ord = 0;
#pragma unroll
        for (int i = 1; i < 4; ++i) { Unit t; if (S.next(i, t) && t.pm == u.pm && t.pn == u.pn) ord = i; }
        const LAS float* rs = rsT + (ord * 256 + wr * 64 + fr) * 2;
#pragma unroll
        for (int ai = 0; ai < 2; ++ai)
#pragma unroll
            for (int m = 0; m < 4; ++m) {
                const size_t r = (size_t)(row0 + ai * HALF + m * 16);
                const float rhh = rs[(ai * HALF + m * 16) * 2], ree = rs[(ai * HALF + m * 16) * 2 + 1];
                float s = 0.f;
#pragma unroll
                for (int bj = 0; bj < 2; ++bj) {
                    const int c = col0 + bj * HALF;
                    const size_t o = r * D + c;
                    const f32x4 b0 = *(const f32x4*)(gb + c), b1 = *(const f32x4*)(gb + c + 4), w0 = *(const f32x4*)(pnw + c), w1 = *(const f32x4*)(pnw + c + 4);
                    const u32x4 ev = *(const u32x4*)(e + o);
                    const u32x4 hv = *(const u32x4*)(hbf + o);
                    f32x4 h0, h1;
                    h0[0] = bflo(hv.x); h0[1] = bfhi(hv.x); h0[2] = bflo(hv.y); h0[3] = bfhi(hv.y); h1[0] = bflo(hv.z); h1[1] = bfhi(hv.z); h1[2] = bflo(hv.w); h1[3] = bfhi(hv.w);
                    f32x4 e0, e1;
                    e0[0] = bflo(ev.x); e0[1] = bfhi(ev.x); e0[2] = bflo(ev.y); e0[3] = bfhi(ev.y);
                    e1[0] = bflo(ev.z); e1[1] = bfhi(ev.z); e1[2] = bflo(ev.w); e1[3] = bfhi(ev.w);
#pragma unroll
                    for (int j = 0; j < 4; ++j) {
                        const float g0 = sigmoidf_(acc[ai][bj][m][0][j] * rhh + b0[j]), g1 = sigmoidf_(acc[ai][bj][m][1][j] * rhh + b1[j]);
                        h0[j] += g0 * (e0[j] * ree * w0[j]); h1[j] += g1 * (e1[j] * ree * w1[j]);
                        s += h0[j] * h0[j] + h1[j] * h1[j];
                    }
                    *(f32x4*)(h + o) = h0; *(f32x4*)(h + o + 4) = h1;
                }
                s += __shfl_xor(s, 16); s += __shfl_xor(s, 32);
                if (fq == 0) h2ss[r * 32 + u.pn * 4 + wc] = s;
                __builtin_amdgcn_sched_barrier(0);
            }
    }
};

__device__ __forceinline__ void transpose_tiles(const float* __restrict__ src, bf16_t* __restrict__ dst, const int K, const int N, const int ntn  , const int ntiles, float* tile  , const int first, const int stride, const float* __restrict__ kscale = nullptr) {
    int tid = threadIdx.x; asm volatile("" : "+v"(tid));
    const int nsn = ntn >> 2, nsuper = ntiles >> 2;
    for (int loc = first; loc < nsuper; loc += stride) {
        const int k0 = (loc / nsn) * 64, n0 = (loc % nsn) * 256;
        f32x4 v[8];
#pragma unroll
        for (int i = 0; i < 8; ++i) {
            const int idx = tid + i * 512, kk = idx >> 6, n4 = (idx & 63) * 4;
            v[i] = (f32x4){0.f, 0.f, 0.f, 0.f};
            if (n0 + n4 < N) v[i] = __builtin_nontemporal_load((const f32x4*)(src + (size_t)(k0 + kk) * N + n0 + n4));
        }
#pragma unroll
        for (int i = 0; i < 8; ++i) {
            const int idx = tid + i * 512, kk = idx >> 6, n4 = (idx & 63) * 4;
            float* tp = tile + kk * 257 + n4; tp[0] = v[i][0]; tp[1] = v[i][1]; tp[2] = v[i][2]; tp[3] = v[i][3];
        }
        __syncthreads();
#pragma unroll
        for (int i = 0; i < 4; ++i) {
            const int idx = tid + i * 512, n = idx >> 3, k8 = (idx & 7) * 8;
            float f[8];
#pragma unroll
            for (int j = 0; j < 8; ++j) f[j] = tile[(k8 + j) * 257 + n];
            if (kscale) { const f32x4 s0 = *(const f32x4*)(kscale + k0 + k8), s1 = *(const f32x4*)(kscale + k0 + k8 + 4);
#pragma unroll
                for (int j = 0; j < 4; ++j) { f[j] *= s0[j]; f[4 + j] *= s1[j]; } }
            u32x4 w; w.x = cvt_pk_bf16(f[0], f[1]); w.y = cvt_pk_bf16(f[2], f[3]); w.z = cvt_pk_bf16(f[4], f[5]); w.w = cvt_pk_bf16(f[6], f[7]);
            *(u32x4*)(dst + (size_t)(n0 + n) * K + k0 + k8) = w;
        }
        __syncthreads();
    }
}

__device__ __forceinline__ void phase_prep(const Args& a, unsigned char* lds) {
    int tid = threadIdx.x; asm volatile("" : "+v"(tid));
    const int wid = tid >> 6, lane = tid & 63;
    bf16_t* U = (bf16_t*)(a.ws + WS_U);
    const float* x = a.in[I_X]; const float* nw = a.in[I_NMW];
    for (int r0 = blockIdx.x * 8 + wid; r0 < T; r0 += gridDim.x * 16) {
        const int r1 = r0 + gridDim.x * 8; const bool has1 = r1 < T;
        const f32x4* xr0 = (const f32x4*)(x + (size_t)r0 * D); const f32x4* xr1 = (const f32x4*)(x + (size_t)(has1 ? r1 : r0) * D);
        f32x4 v0[8], v1[8]; float ss0 = 0.f, ss1 = 0.f;
#pragma unroll
        for (int i = 0; i < 8; ++i) { v0[i] = __builtin_nontemporal_load(xr0 + lane + i * 64); v1[i] = __builtin_nontemporal_load(xr1 + lane + i * 64); }
#pragma unroll
        for (int i = 0; i < 8; ++i) { ss0 += v0[i][0] * v0[i][0] + v0[i][1] * v0[i][1] + v0[i][2] * v0[i][2] + v0[i][3] * v0[i][3];
                                      ss1 += v1[i][0] * v1[i][0] + v1[i][1] * v1[i][1] + v1[i][2] * v1[i][2] + v1[i][3] * v1[i][3]; }
        ss0 = wave_sum(ss0); ss1 = wave_sum(ss1);
        const float rs0 = rsqrtf(ss0 * (1.0f / D) + EPS), rs1 = rsqrtf(ss1 * (1.0f / D) + EPS);
#pragma unroll
        for (int i = 0; i < 8; ++i) {
            const f32x4 w = ((const f32x4*)nw)[lane + i * 64];
            u32x2 o; o.x = cvt_pk_bf16(v0[i][0] * rs0 * w[0], v0[i][1] * rs0 * w[1]); o.y = cvt_pk_bf16(v0[i][2] * rs0 * w[2], v0[i][3] * rs0 * w[3]);
            ((u32x2*)(U + (size_t)r0 * D))[lane + i * 64] = o;
            if (has1) { u32x2 o1; o1.x = cvt_pk_bf16(v1[i][0] * rs1 * w[0], v1[i][1] * rs1 * w[1]); o1.y = cvt_pk_bf16(v1[i][2] * rs1 * w[2], v1[i][3] * rs1 * w[3]);
                ((u32x2*)(U + (size_t)r1 * D))[lane + i * 64] = o1; }
        }
    }
    transpose_tiles(a.in[I_WIN], (bf16_t*)(a.ws + WS_WINT), 2048, DIN, 116, 32 * 116, (float*)lds, blockIdx.x, gridDim.x);
}

constexpr int GS_HG = 16384, GS_GL = 32768;
__device__ __forceinline__ size_t gstate_off(int item) { return item < 128 ? (size_t)item * GS_HG : (size_t)128 * GS_HG + (size_t)(item - 128) * GS_GL; }

__device__ __forceinline__ void load_v128(u32x4 (&v)[2], const bf16_t* vsrc, const int tid) {
#pragma unroll
    for (int i = 0; i < 2; ++i) { const int idx = tid + i * 512, t = (idx >> 2) & 63, ch = (idx & 3) + 4 * (idx >> 8);
        v[i] = *(const u32x4*)(vsrc + (size_t)t * PS + ch * 8); }
}
__device__ __forceinline__ void store_vT128(bf16_t* vT, const u32x4 (&v)[2], const int tid) {
#pragma unroll
    for (int i = 0; i < 2; ++i) { const int idx = tid + i * 512, t = (idx >> 2) & 63, ch = (idx & 3) + 4 * (idx >> 8);
        bf16_t* d = vT + ((ch >> 2) * 32 + (ch & 3) * 4) * 72 + t;
        d[0 * 72] = (bf16_t)(v[i].x & 0xffffu); d[1 * 72] = (bf16_t)(v[i].x >> 16); d[2 * 72] = (bf16_t)(v[i].y & 0xffffu); d[3 * 72] = (bf16_t)(v[i].y >> 16);
        d[16 * 72] = (bf16_t)(v[i].z & 0xffffu); d[17 * 72] = (bf16_t)(v[i].z >> 16); d[18 * 72] = (bf16_t)(v[i].w & 0xffffu); d[19 * 72] = (bf16_t)(v[i].w >> 16); }
}
#define LDS_BARRIER() do { asm volatile("s_waitcnt lgkmcnt(0)" ::: "memory"); __builtin_amdgcn_s_barrier(); asm volatile("" ::: "memory"); } while (0)
template <bool OUT>
__device__ __forceinline__ void recur_pass(const Args& a, unsigned char* lds) {
    int tid = threadIdx.x; asm volatile("" : "+v"(tid));
    const int wid = __builtin_amdgcn_readfirstlane(tid >> 6), seg = __builtin_amdgcn_readfirstlane(tid >> 7);
    bf16_t* qs = (bf16_t*)lds;
    bf16_t* ks = (bf16_t*)(lds + 17408);
    bf16_t* khT = (bf16_t*)(lds + 34816);
    bf16_t* vT = (bf16_t*)(lds + 53248);
    bf16_t* sT = (bf16_t*)(lds + 71680);
    bf16_t* as = (bf16_t*)(lds + 106496);
    float* tot = (float*)(lds + 115712);
    float* decs = (float*)(lds + 117760);
    float* ssb = (float*)(lds + 118272);
    float* w2s = (float*)(lds + 118784);
    float* gls = (float*)(lds + 126976);
    float* nws = (float*)(lds + 131072);
    bf16_t* proj = (bf16_t*)(a.ws + WS_PROJ);
    const float* hg = (const float*)(a.ws + WS_HG);
    const float* glr = (const float*)(a.ws + WS_GLR);
    float* decg = (float*)(a.ws + WS_DEC);
    float* gst = a.out;
    bf16_t* ycat = (bf16_t*)(a.ws + WS_U);
    const int dkb = (wid & 3) * 32, nt0 = (wid >> 2) * 4;
    const int tb = wid & 3, ch = wid >> 2;
    for (int item = blockIdx.x; item < 256; item += gridDim.x) {
        const bool gla = item >= 128;
        int ti_ = tid; asm volatile("" : "+v"(ti_));
        const int c0_ = ti_ & 127, fr0_ = ti_ & 15, fq0_ = (ti_ & 63) >> 4;
        const int h = gla ? (item - 128) >> 5 : item >> 4, grp = gla ? (item - 128) & 31 : item & 15;
        const int G = gla ? 4 : 8, ntile = gla ? 2 : 1, chunk0 = grp * G;
        const int qoff = gla ? 4096 + h * 128 : h * 128;
        const int voff = gla ? 5120 + h * 256 : 2048 + h * 128;
        const int zoff = gla ? 6144 + h * 256 : 3072 + h * 128;
        const int yoff = gla ? 1024 + h * 256 : h * 128;
        const int dvtot = gla ? 256 : 128;
        const float* nw = gla ? a.in[I_GNW] + h * 256 : a.in[I_HNW] + h * 128;
        float* gs_item = gst + gstate_off(item);
        f32x4 S[2][2][4];
#pragma unroll
        for (int t = 0; t < 2; ++t)
#pragma unroll
            for (int n = 0; n < 2; ++n)
#pragma unroll
                for (int nt = 0; nt < 4; ++nt) {
                    S[t][n][nt] = (f32x4){0.f, 0.f, 0.f, 0.f};
                    if (OUT && t < ntile) S[t][n][nt] = *(const f32x4*)(gs_item + (size_t)(t * 128 + (nt0 + nt) * 16 + fr0_) * 128 + dkb + 8 * fq0_ + 4 * n);
                }
        float dprod = 1.0f;
        u32x4 qreg[2], kreg[2], vreg[2][2], zreg[2][2]; f32x4 glreg = (f32x4){0.f, 0.f, 0.f, 0.f};
        float g[16];
#define RP_LOAD_QK(T0) do { \
            if (OUT) { _Pragma("unroll") for (int i = 0; i < 2; ++i) { const int idx = tl_ + i * 512, row = idx >> 4, c8 = (idx & 15) * 8; qreg[i] = *(const u32x4*)(proj + (size_t)((T0) + row) * PS + qoff + c8); } } \
            if (gla) { _Pragma("unroll") for (int i = 0; i < 2; ++i) { const int idx = tl_ + i * 512, row = idx >> 4, c8 = (idx & 15) * 8; kreg[i] = *(const u32x4*)(proj + (size_t)((T0) + row) * PS + qoff + 512 + c8); } } } while (0)
#define RP_LOAD_G(T0) do { if (gla) { if (tl_ < 256) glreg = *(const f32x4*)(glr + (size_t)((T0) + (tl_ >> 2)) * 16 + (tl_ & 3) * 4); } else { _Pragma("unroll") for (int i = 0; i < 16; ++i) g[i] = hg[(size_t)((T0) + seg * 16 + i) * 1024 + h * 128 + (tl_ & 127)]; } } while (0)
#define RP_LOAD_V(T0) do { _Pragma("unroll") for (int t = 0; t < 2; ++t) if (t < ntile) load_v128(vreg[t], proj + (size_t)(T0) * PS + voff + t * 128, tl_); } while (0)
#define RP_LOAD_Z(T0) do { if (OUT) { _Pragma("unroll") for (int t = 0; t < 2; ++t) _Pragma("unroll") for (int p = 0; p < 2; ++p) if (t < ntile) \
            zreg[t][p] = *(const u32x4*)(proj + (size_t)((T0) + tb * 16 + (tl_ & 15)) * PS + zoff + t * 128 + ch * 64 + p * 32 + ((tl_ & 63) >> 4) * 8); } } while (0)
        { int tl_ = tid; asm volatile("" : "+v"(tl_)); const int T0 = chunk0 * 64; RP_LOAD_QK(T0); RP_LOAD_G(T0); RP_LOAD_V(T0); }
        float gbias = 0.f;
        if (OUT && ti_ < dvtot) nws[ti_] = nw[ti_];
        if (gla) {
            const float* w2 = a.in[I_GW2];
#pragma unroll
            for (int r = 0; r < 4; ++r) { const int rr = seg * 4 + r; w2s[rr * 128 + c0_] = w2[rr * 512 + h * 128 + c0_]; }
            gbias = a.in[I_GGB][h * 128 + c0_];
        }
        LDS_BARRIER();
        for (int ci = 0; ci < G; ++ci) {
            const int t0 = (chunk0 + ci) * 64, t0n = t0 + 64; const bool more = ci + 1 < G;
            int tl_ = tid; asm volatile("" : "+v"(tl_));
            const int c = tl_ & 127, fr = tl_ & 15, fq = (tl_ & 63) >> 4, prow = 8 * (fr >> 2) + (fr & 3);
            float b[16];
            if (OUT) {
#pragma unroll
                for (int i = 0; i < 2; ++i) { const int idx = tl_ + i * 512, row = idx >> 4, c8 = (idx & 15) * 8; *(u32x4*)(qs + row * 136 + c8) = qreg[i]; }
            }
            if (gla) {
#pragma unroll
                for (int i = 0; i < 2; ++i) { const int idx = tl_ + i * 512, row = idx >> 4, c8 = (idx & 15) * 8; *(u32x4*)(ks + row * 136 + c8) = kreg[i]; }
                if (tl_ < 256) *(f32x4*)(gls + (tl_ >> 2) * 16 + (tl_ & 3) * 4) = glreg;
            }
            if (gla) LDS_BARRIER();
            if (gla && !OUT) {
                float* gt = (float*)sT;
                const int gtb = wid & 3, gch = wid >> 2;
#pragma unroll
                for (int ct = 0; ct < 4; ++ct) {
                    const int col0 = gch * 64 + ct * 16;
                    f32x4 acc = (f32x4){0.f, 0.f, 0.f, 0.f};
#pragma unroll
                    for (int kk = 0; kk < 4; ++kk)
                        acc = __builtin_amdgcn_mfma_f32_16x16x4f32(gls[(gtb * 16 + fr) * 16 + kk * 4 + fq], w2s[(kk * 4 + fq) * 128 + col0 + fr], acc, 0, 0, 0);
#pragma unroll
                    for (int e = 0; e < 4; ++e) gt[(gtb * 16 + 4 * fq + e) * 136 + col0 + fr] = acc[e];
                }
                LDS_BARRIER();
#pragma unroll
                for (int i = 0; i < 16; ++i) {
                    const float sacc = gt[(seg * 16 + i) * 136 + c] + gbias;
                    g[i] = (fminf(sacc, 0.f) - __logf(1.0f + __expf(-fabsf(sacc)))) * (1.0f / 16.0f);
                }
            } else if (gla) {
                float wv[16];
#pragma unroll
                for (int r = 0; r < 16; ++r) wv[r] = w2s[r * 128 + c];
#pragma unroll
                for (int i = 0; i < 16; ++i) {
                    const float* gl = gls + (seg * 16 + i) * 16;
                    float sacc = gbias;
#pragma unroll
                    for (int r4 = 0; r4 < 4; ++r4) { const f32x4 gv = *(const f32x4*)(gl + r4 * 4);
                        sacc += gv[0] * wv[r4 * 4] + gv[1] * wv[r4 * 4 + 1] + gv[2] * wv[r4 * 4 + 2] + gv[3] * wv[r4 * 4 + 3]; }
                    g[i] = (fminf(sacc, 0.f) - __logf(1.0f + __expf(-fabsf(sacc)))) * (1.0f / 16.0f);
                }
            }
            b[0] = g[0];
            if (gla) {
#pragma unroll
                for (int i = 1; i < 16; ++i) b[i] = b[i - 1] + g[i];
            } else {
#pragma unroll
                for (int i = 1; i < 16; ++i) b[i] = b[i - 1] * g[i];
            }
            tot[seg * 128 + c] = b[15];
            LDS_BARRIER();
            float dlast;
            float kv[16];
            if (gla) {
                float pre = 0.f, blast = 0.f;
#pragma unroll
                for (int s4 = 0; s4 < 4; ++s4) { const float tv = tot[s4 * 128 + c]; if (s4 < seg) pre += tv; blast += tv; }
                dlast = __expf(blast);
#pragma unroll
                for (int i = 0; i < 16; ++i) { kv[i] = bf2f(ks[(seg * 16 + i) * 136 + c]); b[i] = __expf(b[i] + pre); }
            } else {
                float pre = 1.f, plast = 1.f;
#pragma unroll
                for (int s4 = 0; s4 < 4; ++s4) { const float tv = tot[s4 * 128 + c]; if (s4 < seg) pre *= tv; plast *= tv; }
                dlast = plast;
#pragma unroll
                for (int i = 0; i < 16; ++i) { kv[i] = 1.0f - g[i]; b[i] *= pre; }
            }
            {
                unsigned kh[8];
#pragma unroll
                for (int i = 0; i < 16; i += 2) {
                    float khv[2];
#pragma unroll
                    for (int e = 0; e < 2; ++e) {
                        const int ii = i + e, tl = seg * 16 + ii;
                        const float eb = b[ii];
                        const float k = kv[ii];
                        const float kinv = k * __builtin_amdgcn_rcpf(eb);
                        if (OUT) {
                            const float q = bf2f(qs[tl * 136 + c]);
                            qs[tl * 136 + c] = f2bf(q * eb);
                            ks[tl * 136 + c] = f2bf(kinv);
                        }
                        khv[e] = kinv * dlast;
                    }
                    kh[i >> 1] = cvt_pk_bf16(khv[0], khv[1]);
                }
                const int cs = (c & ~31) + 16 * ((c >> 2) & 1) + 4 * ((c >> 3) & 3) + (c & 3);
                *(u32x4*)(khT + cs * 72 + seg * 16) = (u32x4){kh[0], kh[1], kh[2], kh[3]};
                *(u32x4*)(khT + cs * 72 + seg * 16 + 8) = (u32x4){kh[4], kh[5], kh[6], kh[7]};
            }
            const float dch = dlast;
            if (seg == 0) decs[c] = dch;
            dprod *= dch;
            LDS_BARRIER();
            RP_LOAD_Z(t0);
            if (OUT) {
#pragma unroll
                for (int rep = 0; rep < 2; ++rep) {
                    const int idx = wid + rep * 8, ti = idx >> 2, tj = idx & 3;
                    f32x4 acc = (f32x4){0.f, 0.f, 0.f, 0.f};
                    if (tj <= ti) {
#pragma unroll
                        for (int kk = 0; kk < 4; ++kk) {
                            const bf16x8 af = *(const bf16x8*)(ks + (tj * 16 + fr) * 136 + kk * 32 + fq * 8);
                            const bf16x8 bf = *(const bf16x8*)(qs + (ti * 16 + fr) * 136 + kk * 32 + fq * 8);
                            acc = __builtin_amdgcn_mfma_f32_16x16x32_bf16(af, bf, acc, 0, 0, 0);
                        }
                    }
                    const int i_ = ti * 16 + fr, j0 = tj * 16 + fq * 4;
                    u32x2 o;
                    o.x = cvt_pk_bf16(j0 + 0 <= i_ ? acc[0] : 0.f, j0 + 1 <= i_ ? acc[1] : 0.f);
                    o.y = cvt_pk_bf16(j0 + 2 <= i_ ? acc[2] : 0.f, j0 + 3 <= i_ ? acc[3] : 0.f);
                    *(u32x2*)(as + i_ * 72 + j0) = o;
                }
            }
            float dsc[2][4];
#pragma unroll
            for (int n = 0; n < 2; ++n)
#pragma unroll
                for (int e = 0; e < 4; ++e) dsc[n][e] = decs[dkb + 8 * fq + 4 * n + e];
            bf16x8 af[2][2];
#pragma unroll
            for (int n = 0; n < 2; ++n)
#pragma unroll
                for (int kk = 0; kk < 2; ++kk) af[n][kk] = *(const bf16x8*)(khT + (dkb + n * 16 + fr) * 72 + kk * 32 + fq * 8);
            f32x4 ao[2][4];
            float ss = 0.f;
#pragma unroll
            for (int t = 0; t < 2; ++t) {
#pragma unroll
                for (int x = 0; x < 4; ++x) ao[t][x] = (f32x4){0.f, 0.f, 0.f, 0.f};
                if (t < ntile) {
                    store_vT128(vT, vreg[t], tl_);
                    if (OUT) {
#pragma unroll
                        for (int nt = 0; nt < 4; ++nt) {
                            u32x4 o; o.x = cvt_pk_bf16(S[t][0][nt][0], S[t][0][nt][1]); o.y = cvt_pk_bf16(S[t][0][nt][2], S[t][0][nt][3]);
                            o.z = cvt_pk_bf16(S[t][1][nt][0], S[t][1][nt][1]); o.w = cvt_pk_bf16(S[t][1][nt][2], S[t][1][nt][3]);
                            *(u32x4*)(sT + ((nt0 + nt) * 16 + fr) * 136 + dkb + 8 * fq) = o;
                        }
                    }
                    LDS_BARRIER();
                    if (OUT) {
                        bf16x8 ba[2], bq[4];
#pragma unroll
                        for (int kk = 0; kk < 2; ++kk) ba[kk] = *(const bf16x8*)(as + (tb * 16 + fr) * 72 + kk * 32 + fq * 8);
#pragma unroll
                        for (int kk = 0; kk < 4; ++kk) bq[kk] = *(const bf16x8*)(qs + (tb * 16 + fr) * 136 + kk * 32 + fq * 8);
#pragma unroll
                        for (int p = 0; p < 2; ++p)
#pragma unroll
                            for (int n = 0; n < 2; ++n) {
                                const int dvr = ch * 64 + p * 32 + n * 16 + fr;
                                f32x4 acc = (f32x4){0.f, 0.f, 0.f, 0.f};
#pragma unroll
                                for (int kk = 0; kk < 2; ++kk) acc = __builtin_amdgcn_mfma_f32_16x16x32_bf16(*(const bf16x8*)(vT + dvr * 72 + kk * 32 + fq * 8), ba[kk], acc, 0, 0, 0);
#pragma unroll
                                for (int kk = 0; kk < 4; ++kk) acc = __builtin_amdgcn_mfma_f32_16x16x32_bf16(*(const bf16x8*)(sT + dvr * 136 + kk * 32 + fq * 8), bq[kk], acc, 0, 0, 0);
                                ao[t][p * 2 + n] = acc;
                                ss += acc[0] * acc[0] + acc[1] * acc[1] + acc[2] * acc[2] + acc[3] * acc[3];
                                __builtin_amdgcn_sched_barrier(0);
                            }
                    }
#pragma unroll
                    for (int nt = 0; nt < 4; ++nt) {
                        const bf16x8 b0 = *(const bf16x8*)(vT + ((nt0 + nt) * 16 + fr) * 72 + fq * 8), b1 = *(const bf16x8*)(vT + ((nt0 + nt) * 16 + fr) * 72 + 32 + fq * 8);
#pragma unroll
                        for (int n = 0; n < 2; ++n) {
                            f32x4 sv = S[t][n][nt];
#pragma unroll
                            for (int e = 0; e < 4; ++e) sv[e] *= dsc[n][e];
                            sv = __builtin_amdgcn_mfma_f32_16x16x32_bf16(af[n][0], b0, sv, 0, 0, 0);
                            sv = __builtin_amdgcn_mfma_f32_16x16x32_bf16(af[n][1], b1, sv, 0, 0, 0);
                            S[t][n][nt] = sv;
                        }
                        __builtin_amdgcn_sched_barrier(0);
                    }
                    if (t + 1 < ntile) LDS_BARRIER();
                }
            }
            if (more) { RP_LOAD_QK(t0n); RP_LOAD_G(t0n); RP_LOAD_V(t0n); }
            if (OUT) {
                ss += __shfl_xor(ss, 16); ss += __shfl_xor(ss, 32);
                if (fq == 0) ssb[ch * 64 + tb * 16 + fr] = ss;
                LDS_BARRIER();
                const float rstd = rsqrtf((ssb[tb * 16 + fr] + ssb[64 + tb * 16 + fr]) / (float)dvtot + EPS);
                const size_t trow = (size_t)(t0 + tb * 16 + fr);
#pragma unroll
                for (int t = 0; t < 2; ++t)
#pragma unroll
                    for (int p = 0; p < 2; ++p) {
                        if (t < ntile) {
                            const int d0 = t * 128 + ch * 64 + p * 32 + fq * 8;
                            const f32x4 w0 = *(const f32x4*)(nws + d0), w1 = *(const f32x4*)(nws + d0 + 4);
                            const u32x4 z = zreg[t][p];
                            const f32x4 x0 = ao[t][p * 2], x1 = ao[t][p * 2 + 1];
                            u32x4 o;
                            o.x = cvt_pk_bf16(x0[0] * rstd * w0[0] * bflo(z.x), x0[1] * rstd * w0[1] * bfhi(z.x));
                            o.y = cvt_pk_bf16(x0[2] * rstd * w0[2] * bflo(z.y), x0[3] * rstd * w0[3] * bfhi(z.y));
                            o.z = cvt_pk_bf16(x1[0] * rstd * w1[0] * bflo(z.z), x1[1] * rstd * w1[1] * bfhi(z.z));
                            o.w = cvt_pk_bf16(x1[2] * rstd * w1[2] * bflo(z.w), x1[3] * rstd * w1[3] * bfhi(z.w));
                            *(u32x4*)(ycat + trow * D + yoff + d0) = o;
                        }
                    }
            }
        }
#undef RP_LOAD_QK
#undef RP_LOAD_G
#undef RP_LOAD_V
#undef RP_LOAD_Z
        if (!OUT) {
            int te_ = tid; asm volatile("" : "+v"(te_));
            const int c0_ = te_ & 127, fr0_ = te_ & 15, fq0_ = (te_ & 63) >> 4;
#pragma unroll
            for (int t = 0; t < 2; ++t)
#pragma unroll
                for (int n = 0; n < 2; ++n)
#pragma unroll
                    for (int nt = 0; nt < 4; ++nt)
                        if (t < ntile) *(f32x4*)(gs_item + (size_t)(t * 128 + (nt0 + nt) * 16 + fr0_) * 128 + dkb + 8 * fq0_ + 4 * n) = S[t][n][nt];
            if (seg == 0) decg[(size_t)item * 128 + c0_] = dprod;
        }
    }
}

__device__ __forceinline__ void recur_scan(const Args& a) {
    float* gst = a.out; const float* decg = (const float*)(a.ws + WS_DEC);
    for (int e2 = blockIdx.x * 512 + threadIdx.x; e2 < 131072; e2 += gridDim.x * 512) {
        const bool gla = e2 >= 65536;
        const int e = (gla ? e2 - 65536 : e2) * 2;
        const int h = gla ? e >> 15 : e >> 14, idx = gla ? e & 32767 : e & 16383, dk = idx & 127;
        const int ng = gla ? 32 : 16, item0 = gla ? 128 + h * 32 : h * 16;
        const size_t gsz = gla ? GS_GL : GS_HG;
        float* p = gst + gstate_off(item0) + idx;
        const float* dp = decg + (size_t)item0 * 128 + dk;
        float s0 = 0.f, s1 = 0.f;
        for (int g0 = 0; g0 < ng; g0 += 8) {
            f32x2 d[8], dc[8];
#pragma unroll
            for (int i = 0; i < 8; ++i) { d[i] = *(const f32x2*)(p + (size_t)(g0 + i) * gsz); dc[i] = *(const f32x2*)(dp + (size_t)(g0 + i) * 128); }
#pragma unroll
            for (int i = 0; i < 8; ++i) {
                *(f32x2*)(p + (size_t)(g0 + i) * gsz) = (f32x2){s0, s1};
                s0 = dc[i][0] * s0 + d[i][0]; s1 = dc[i][1] * s1 + d[i][1];
            }
        }
    }
}

__device__ __forceinline__ void phase_final(const Args& a) {
    const int tid = threadIdx.x, wid = tid >> 6, lane = tid & 63;
    const float* h2ss = (const float*)(a.ws + WS_H2SS); const float* fw = a.in[I_FNW];
    for (int r = blockIdx.x * 8 + wid; r < T; r += gridDim.x * 8) {
        float s = lane < 32 ? h2ss[(size_t)r * 32 + lane] : 0.f;
        s = wave_sum(s);
        const float rstd = rsqrtf(s * (1.0f / D) + EPS);
        f32x4* o = (f32x4*)(a.out + (size_t)r * D);
#pragma unroll
        for (int i = 0; i < 8; ++i) { const f32x4 w = ((const f32x4*)fw)[lane + i * 64]; f32x4 v = o[lane + i * 64]; v = v * rstd * w; o[lane + i * 64] = v; }
    }
}

#define XB_TMO      128
#define XB_XCNT(j)  (256  + 64 * (j))
#define XB_XSUB(j)  (1280 + 64 * (j))
#define XB_XGEN(j)  (2304 + 64 * (j))
#define XB_TOP      3328
#define XB_TOPGEN   3392
#define XCD_BAR_WORDS 3456
#define XB_SPIN_CAP (1u << 18)

__device__ __forceinline__ unsigned xb_ld(unsigned* p)              { return __hip_atomic_load(p, __ATOMIC_RELAXED, __HIP_MEMORY_SCOPE_AGENT); }
__device__ __forceinline__ unsigned xb_add(unsigned* p, unsigned v) { return __hip_atomic_fetch_add(p, v, __ATOMIC_RELAXED, __HIP_MEMORY_SCOPE_AGENT); }
__device__ __forceinline__ unsigned xb_xcc_id() { return (unsigned)__builtin_amdgcn_s_getreg((3 << 11) | 20) & 0xFu; }
#define XB_SPIN(cond, bar) do { unsigned _sp = 0; while (cond) { __builtin_amdgcn_s_sleep(1); \
    if ((++_sp & 255u) == 0u) { if (xb_ld(&(bar)[XB_TMO])) break; if (_sp > XB_SPIN_CAP) { atomicAdd(&(bar)[XB_TMO], 1u); break; } } } } while (0)

struct XcdBarrier {
    unsigned* bar; unsigned x;
    volatile LAS unsigned* st;
};

__device__ __forceinline__ XcdBarrier xcd_barrier_post(unsigned* bar, volatile LAS unsigned* st) {
    XcdBarrier b; b.bar = bar; b.x = xb_xcc_id(); b.st = st;
    if (threadIdx.x == 0) (void)xb_add(&bar[XB_XCNT(b.x)], 1u);
    return b;
}
__device__ __forceinline__ void xcd_barrier_complete(unsigned* bar, unsigned x, unsigned& nloc, unsigned& nx) {
    const unsigned G = gridDim.x * gridDim.y * gridDim.z;
    unsigned sum, cnt, mine, sp = 0u;
    for (;;) {
        sum = 0u; cnt = 0u; mine = 0u;
#pragma unroll
        for (unsigned j = 0; j < 16; ++j) { const unsigned c = xb_ld(&bar[XB_XCNT(j)]); sum += c; cnt += (c > 0u) ? 1u : 0u; mine = (j == x) ? c : mine; }
        if (sum == G) break;
        __builtin_amdgcn_s_sleep(1);
        if ((++sp & 255u) == 0u) { if (xb_ld(&bar[XB_TMO])) break; if (sp > XB_SPIN_CAP) { atomicAdd(&bar[XB_TMO], 1u); break; } }
    }
    nloc = mine > 0u ? mine : 1u; nx = cnt > 0u ? cnt : 1u;
}

__device__ __forceinline__ void xcd_barrier(const XcdBarrier& b) {
    asm volatile("s_waitcnt vmcnt(0)" ::: "memory");
    __syncthreads();
    if (threadIdx.x == 0) {
        unsigned* bar = b.bar;
        __builtin_amdgcn_s_waitcnt(0);
        unsigned nloc = b.st[0], nx = b.st[1];
        if (nloc == 0u) { xcd_barrier_complete(bar, b.x, nloc, nx); b.st[0] = nloc; b.st[1] = nx; }
        const unsigned old = xb_add(&bar[XB_XSUB(b.x)], 1u);
        const unsigned gen = old / nloc;
        if (old + 1u == (gen + 1u) * nloc) {
            __builtin_amdgcn_fence(__ATOMIC_RELEASE, "agent");
            asm volatile("s_waitcnt vmcnt(0)" ::: "memory");
            const unsigned og = xb_add(&bar[XB_TOP], 1u);
            const unsigned tg = og / nx;
            if (og + 1u == (tg + 1u) * nx) xb_add(&bar[XB_TOPGEN], 1u);
            else XB_SPIN(xb_ld(&bar[XB_TOPGEN]) == tg, bar);
            __builtin_amdgcn_fence(__ATOMIC_ACQUIRE, "agent");
            xb_add(&bar[XB_XGEN(b.x)], 1u);
            asm volatile("s_waitcnt vmcnt(0)" ::: "memory");
        } else {
            XB_SPIN(xb_ld(&bar[XB_XGEN(b.x)]) == gen, bar);
            __builtin_amdgcn_fence(__ATOMIC_ACQUIRE, "agent");
            asm volatile("s_waitcnt vmcnt(0)" ::: "memory");
        }
    }
    __syncthreads();
}


struct Epi4F {
    static constexpr bool PERM = true, AFTER_DRAIN = true;
    const bf16_t* e; const float* gb; const float* pnw; const bf16_t* hbf; float* out; const float* fnw; unsigned* xs; unsigned* cnt; unsigned* bar;
    __device__ __forceinline__ void operator()(const f32x4 (&)[2][2][4][2], const Unit&, int, int, int, int) const {}
    __device__ __forceinline__ void fused(f32x4 (&acc)[2][2][4][2], const Unit& u, int wr, int wc, int fr, int fq, LAS unsigned char* lds) const {
        asm volatile("" : "+v"(fr), "+v"(fq));
        const int row0 = u.pm * BM + wr * 64 + fr, col0 = u.pn * BM + wc * 32 + 8 * fq;
        const LAS float* rs = (const LAS float*)(lds + STAGE_BYTES) + (wr * 64 + fr) * 2;
        LAS float* part = (LAS float*)lds;
        LAS float* rstd2 = (LAS float*)(lds + 4096);
#pragma unroll
        for (int ai = 0; ai < 2; ++ai)
#pragma unroll
            for (int m = 0; m < 4; ++m) {
                const size_t r = (size_t)(row0 + ai * HALF + m * 16);
                const float rhh = rs[(ai * HALF + m * 16) * 2], ree = rs[(ai * HALF + m * 16) * 2 + 1];
                float s = 0.f;
#pragma unroll
                for (int bj = 0; bj < 2; ++bj) {
                    const int c = col0 + bj * HALF;
                    const size_t o = r * D + c;
                    const f32x4 b0 = *(const f32x4*)(gb + c), b1 = *(const f32x4*)(gb + c + 4), w0 = *(const f32x4*)(pnw + c), w1 = *(const f32x4*)(pnw + c + 4);
                    const u32x4 ev = *(const u32x4*)(e + o);
                    const u32x4 hv = *(const u32x4*)(hbf + o);
                    f32x4 h0, h1;
                    h0[0] = bflo(hv.x); h0[1] = bfhi(hv.x); h0[2] = bflo(hv.y); h0[3] = bfhi(hv.y); h1[0] = bflo(hv.z); h1[1] = bfhi(hv.z); h1[2] = bflo(hv.w); h1[3] = bfhi(hv.w);
                    f32x4 e0, e1;
                    e0[0] = bflo(ev.x); e0[1] = bfhi(ev.x); e0[2] = bflo(ev.y); e0[3] = bfhi(ev.y);
                    e1[0] = bflo(ev.z); e1[1] = bfhi(ev.z); e1[2] = bflo(ev.w); e1[3] = bfhi(ev.w);
#pragma unroll
                    for (int j = 0; j < 4; ++j) {
                        const float g0 = sigmoidf_(acc[ai][bj][m][0][j] * rhh + b0[j]), g1 = sigmoidf_(acc[ai][bj][m][1][j] * rhh + b1[j]);
                        h0[j] += g0 * (e0[j] * ree * w0[j]); h1[j] += g1 * (e1[j] * ree * w1[j]);
                        s += h0[j] * h0[j] + h1[j] * h1[j];
                    }
                    acc[ai][bj][m][0] = h0; acc[ai][bj][m][1] = h1;
                }
                s += __shfl_xor(s, 16); s += __shfl_xor(s, 32);
                if (fq == 0) part[(wr * 64 + fr + ai * HALF + m * 16) * 4 + wc] = s;
            }
        __syncthreads();
        const int tid = threadIdx.x;
        if (tid < 256) {
            const float sum = (part[tid * 4 + 0] + part[tid * 4 + 1]) + (part[tid * 4 + 2] + part[tid * 4 + 3]);
            __hip_atomic_store(xs + ((size_t)(u.pm * 8 + u.pn) * 256 + tid), __float_as_uint(sum), __ATOMIC_RELAXED, __HIP_MEMORY_SCOPE_AGENT);
        }
        asm volatile("s_waitcnt vmcnt(0)" ::: "memory");
        __syncthreads();
        if (tid == 0) {
            (void)xb_add(cnt + u.pm * 64, 1u);
            XB_SPIN(xb_ld(cnt + u.pm * 64) < 8u, bar);
        }
        __syncthreads();
        if (tid < 256) {
            float sum = 0.f;
#pragma unroll
            for (int k = 0; k < 8; ++k) sum += __uint_as_float(__hip_atomic_load(xs + ((size_t)(u.pm * 8 + k) * 256 + tid), __ATOMIC_RELAXED, __HIP_MEMORY_SCOPE_AGENT));
            rstd2[tid] = rsqrtf(sum * (1.0f / D) + EPS);
        }
        __syncthreads();
#pragma unroll
        for (int ai = 0; ai < 2; ++ai)
#pragma unroll
            for (int m = 0; m < 4; ++m) {
                const size_t r = (size_t)(row0 + ai * HALF + m * 16);
                const float rr = rstd2[wr * 64 + fr + ai * HALF + m * 16];
#pragma unroll
                for (int bj = 0; bj < 2; ++bj) {
                    const int c = col0 + bj * HALF;
                    const f32x4 f0 = *(const f32x4*)(fnw + c), f1 = *(const f32x4*)(fnw + c + 4);
                    *(f32x4*)(out + r * D + c) = acc[ai][bj][m][0] * rr * f0; *(f32x4*)(out + r * D + c + 4) = acc[ai][bj][m][1] * rr * f1;
                }
                __builtin_amdgcn_sched_barrier(0);
            }
    }
};

constexpr int N_PHASES = 8;
#ifndef PHASE_MASK
#define PHASE_MASK 0xff
#endif
#define PH_ON(p) ((PHASE_MASK >> (p)) & 1)
__global__ void __launch_bounds__(512, 2) fwd_kernel(Args a) {
    extern __shared__ __attribute__((aligned(16))) unsigned char lds[];
    cg::grid_group grid = cg::this_grid();
    if (a.ph_lo < 0) grid.sync();
    if (threadIdx.x == 0) { volatile LAS unsigned* st = (volatile LAS unsigned*)(((LAS unsigned char*)lds) + LDS_XB); st[0] = 0u; st[1] = 0u; }
    __syncthreads();
    const XcdBarrier xb = xcd_barrier_post((unsigned*)(a.ws + WS_BAR), (volatile LAS unsigned*)(((LAS unsigned char*)lds) + LDS_XB));
    const bool fuse_final = (gridDim.x == 256) && (a.ph_hi - a.ph_lo == N_PHASES);
#define RUN(p) (PH_ON(p) && a.ph_lo <= (p) && (p) < a.ph_hi)
#define SEAM(p) do { if (a.ph_lo < (p)) xcd_barrier(xb); } while (0)
    {
        if (RUN(0)) {
            phase_prep(a, lds);
        }
        if (RUN(1)) { SEAM(1);
            Gemm g{(const bf16_t*)(a.ws + WS_U), (const bf16_t*)(a.ws + WS_WINT), T, NPAD, D};
            StaticOrder S; S.init(T, NPAD, (int)gridDim.x, (int)blockIdx.x, 1);
            Epi1 E{(bf16_t*)(a.ws + WS_PROJ), (float*)(a.ws + WS_HG), (float*)(a.ws + WS_GLR), a.in[I_HLB]};
            gemm_phase(((LAS unsigned char*)lds), g, S, E);
            {
                const int G = (int)gridDim.x, R = (S.nwg + G - 1) / G; int c0 = S.nwg - (R - 1) * G; if (c0 >= G) c0 = 0;
                if ((int)blockIdx.x >= c0) {
                    transpose_tiles(a.in[I_WOUT], (bf16_t*)(a.ws + WS_WOUTT), 2048, 2048, 32, 32 * 32, (float*)lds, (int)blockIdx.x - c0, G - c0);
                    transpose_tiles(a.in[I_PGW], (bf16_t*)(a.ws + WS_WGT), 2048, 2048, 32, 32 * 32, (float*)lds, (int)blockIdx.x - c0, G - c0, a.in[I_PGNW]);
                    transpose_tiles(a.in[I_PPROJ], (bf16_t*)(a.ws + WS_WPT), 256, 2048, 32, 4 * 32, (float*)lds, (int)blockIdx.x - c0, G - c0);
                    {
                        const f32x4* p4 = (const f32x4*)a.in[I_P]; u32x2* pb = (u32x2*)(a.ws + WS_PB);
                        for (int i = ((int)blockIdx.x - c0) * 512 + (int)threadIdx.x; i < T * 256 / 4; i += (G - c0) * 512) {
                            const f32x4 v = __builtin_nontemporal_load(p4 + i); u32x2 o; o.x = cvt_pk_bf16(v[0], v[1]); o.y = cvt_pk_bf16(v[2], v[3]); pb[i] = o;
                        }
                    }
                }
            }
        }
        if (RUN(2)) { SEAM(2);
            recur_pass<false>(a, lds);
        }
        if (RUN(3)) { SEAM(3);
            recur_scan(a);
        }
        if (RUN(4)) { SEAM(4);
            recur_pass<true>(a, lds);
        }
        if (RUN(5)) { SEAM(5);
            { Gemm g{(const bf16_t*)(a.ws + WS_U), (const bf16_t*)(a.ws + WS_WOUTT), T, D, D};
              StaticOrder S; S.init(T, D, (int)gridDim.x, (int)blockIdx.x);
              Epi2 E{a.in[I_X], (bf16_t*)(a.ws + WS_PROJ), (float*)(a.ws + WS_HSS)};
              gemm_phase(((LAS unsigned char*)lds), g, S, E); }
            { Gemm g{(const bf16_t*)(a.ws + WS_PB), (const bf16_t*)(a.ws + WS_WPT), T, D, 256};
              StaticOrder S; S.init(T, D, (int)gridDim.x, (int)blockIdx.x);
              Epi3 E{(bf16_t*)(a.ws + WS_HG), (float*)(a.ws + WS_ESS)};
              gemm_phase(((LAS unsigned char*)lds), g, S, E); }
        }
        if (RUN(6)) { SEAM(6);
            Gemm g{(const bf16_t*)(a.ws + WS_PROJ), (const bf16_t*)(a.ws + WS_WGT), T, D, D};
            StaticOrder S; S.init(T, D, (int)gridDim.x, (int)blockIdx.x);
            {
                LAS float* rsT = (LAS float*)(((LAS unsigned char*)lds) + STAGE_BYTES);
                const float* hss = (const float*)(a.ws + WS_HSS); const float* ess = (const float*)(a.ws + WS_ESS);
                for (int i = 0; i < 4; ++i) { Unit u; if (!S.next(i, u)) break;
                    const int row = threadIdx.x >> 1, which = threadIdx.x & 1;
                    const float* src = (which ? ess : hss) + (size_t)(u.pm * BM + row) * 32;
                    float sum = 0.f;
#pragma unroll
                    for (int k = 0; k < 8; ++k) { const f32x4 v = *(const f32x4*)(src + 4 * k); sum += (v[0] + v[1]) + (v[2] + v[3]); }
                    rsT[(i * 256 + row) * 2 + which] = rsqrtf(sum * (1.0f / D) + EPS);
                }
                __syncthreads();
            }
            if (fuse_final) {
                Epi4F E{(const bf16_t*)(a.ws + WS_HG), a.in[I_PGB], a.in[I_PNW], (const bf16_t*)(a.ws + WS_PROJ), a.out, a.in[I_FNW], (unsigned*)(a.ws + WS_XS), (unsigned*)(a.ws + WS_CNT), (unsigned*)(a.ws + WS_BAR)};
                gemm_phase(((LAS unsigned char*)lds), g, S, E);
            } else {
                Epi4 E{(const bf16_t*)(a.ws + WS_HG), a.in[I_PGB], a.in[I_PNW], (const bf16_t*)(a.ws + WS_PROJ), a.out, (float*)(a.ws + WS_H2SS), (const LAS float*)(((LAS unsigned char*)lds) + STAGE_BYTES), S};
                gemm_phase(((LAS unsigned char*)lds), g, S, E);
            }
        }
        if (RUN(7) && !fuse_final) { SEAM(7);
            phase_final(a);
        }
    }
}


extern "C" void kernel_launch(void* const* d_in, const int* in_sizes, int n_in, void* d_out, int out_size, void* d_ws, size_t ws_size, hipStream_t stream) {
    static int grid_blocks = 0;
    if (!grid_blocks) {
        int dev = 0, cus = 0, per_cu = 0;
        hipGetDevice(&dev);
        hipDeviceGetAttribute(&cus, hipDeviceAttributeMultiprocessorCount, dev);
        hipFuncSetAttribute((const void*)fwd_kernel, hipFuncAttributeMaxDynamicSharedMemorySize, LDS_BYTES);
        hipOccupancyMaxActiveBlocksPerMultiprocessor(&per_cu, fwd_kernel, 512, LDS_BYTES);
        if (per_cu < 1) { fprintf(stderr, "kernel_launch: occupancy query says %d blocks per CU\n", per_cu); per_cu = 1; }
        grid_blocks = cus * 1;
        if (n_in != 16 || ws_size < WS_END) fprintf(stderr, "kernel_launch: unexpected n_in %d / ws_size %zu (need %zu)\n", n_in, ws_size, (size_t)WS_END);
    }
    Args a{};
    for (int i = 0; i < 16; ++i) a.in[i] = (const float*)d_in[i];
    a.out = (float*)d_out; a.ws = (unsigned char*)d_ws;
#if MK_MULTI
    for (int ph = 0; ph < N_PHASES; ++ph) {
        a.ph_lo = ph; a.ph_hi = ph + 1;
        hipLaunchKernelGGL(fwd_kernel, dim3(grid_blocks), dim3(512), LDS_BYTES, stream, a);
    }
#else
    a.ph_lo = 0; a.ph_hi = N_PHASES;
    hipMemsetAsync((unsigned char*)d_ws + WS_BAR, 0, 16384 + 8192, stream);
    void* kargs[] = {&a};
    hipError_t e = hipLaunchCooperativeKernel((const void*)fwd_kernel, dim3(grid_blocks), dim3(512), kargs, LDS_BYTES, stream);
    if (e != hipSuccess) fprintf(stderr, "cooperative launch failed: %s (grid %d)\n", hipGetErrorString(e), grid_blocks);
#endif
}
```

```cpp
#include <hip/hip_runtime.h>
#include <hip/hip_cooperative_groups.h>
#include <cstdio>
namespace cg = cooperative_groups;

#ifndef MK_MULTI
#define MK_MULTI 0
#endif

#define LAS __attribute__((address_space(3)))
typedef unsigned short bf16_t;
typedef short bf16x8 __attribute__((ext_vector_type(8)));
typedef float f32x4 __attribute__((ext_vector_type(4)));
typedef unsigned u32x4 __attribute__((ext_vector_type(4)));
typedef unsigned u32x2 __attribute__((ext_vector_type(2)));

constexpr int T = 8192, D = 2048, DIN = 7184, NPAD = 7424, PS = 7168  ;
constexpr int NCHUNK = 128, NITEM = NCHUNK * 12, SELEM = 262144;
constexpr float EPS = 1e-6f;
constexpr float QSCALE = 0.08838834764831845f;

constexpr size_t WS_U = 0;
constexpr size_t WS_WINT = WS_U + (size_t)T * D * 2;
constexpr size_t WS_PB = WS_WINT + (size_t)NPAD * D * 2;
constexpr size_t WS_WPT = WS_PB + (size_t)T * 256 * 2;
constexpr size_t WS_WOUTT = WS_WPT + (size_t)D * 256 * 2;
constexpr size_t WS_WGT = WS_WOUTT + (size_t)D * D * 2;
constexpr size_t WS_PROJ = WS_WGT + (size_t)D * D * 2;
constexpr size_t WS_HG = WS_PROJ + (size_t)T * PS * 2;
constexpr size_t WS_GLR = WS_HG + (size_t)T * 1024 * 4;
constexpr size_t WS_DEC = WS_GLR + (size_t)T * 16 * 4;
constexpr size_t WS_HSS = WS_DEC + (size_t)NCHUNK * 12 * 128 * 4;
constexpr size_t WS_ESS = WS_HSS + (size_t)T * 32 * 4;
constexpr size_t WS_H2SS = WS_ESS + (size_t)T * 32 * 4;
constexpr size_t WS_END = WS_H2SS + (size_t)T * 32 * 4;
constexpr size_t WS_BAR = (WS_END + 255) & ~(size_t)255;
constexpr size_t WS_CNT = WS_BAR + 16384;
constexpr size_t WS_XS = WS_CNT + 8192;
constexpr int LDS_XB = 139264;
constexpr int LDS_BYTES = 140 * 1024;

struct Args { const float* in[16]; float* out; unsigned char* ws; int ph_lo, ph_hi; };
enum { I_X = 0, I_P, I_NMW, I_WIN, I_HLB, I_GW2, I_GGB, I_HNW, I_GNW, I_WOUT, I_PPROJ, I_PNW, I_PGNW, I_PGW, I_PGB, I_FNW };

typedef __bf16 bf16v2 __attribute__((ext_vector_type(2)));
typedef float f32x2 __attribute__((ext_vector_type(2)));
__device__ __forceinline__ unsigned cvt_pk_bf16(float lo, float hi) { const f32x2 v = {lo, hi}; const bf16v2 b = __builtin_convertvector(v, bf16v2); return __builtin_bit_cast(unsigned, b); }
__device__ __forceinline__ bf16_t f2bf(float f) { return (bf16_t)(cvt_pk_bf16(f, 0.f) & 0xffffu); }
__device__ __forceinline__ float bf2f(unsigned b) { return __uint_as_float(b << 16); }
__device__ __forceinline__ float bflo(unsigned w) { return __uint_as_float(w << 16); }
__device__ __forceinline__ float bfhi(unsigned w) { return __uint_as_float(w & 0xffff0000u); }
__device__ __forceinline__ float wave_sum(float v) {
#pragma unroll
    for (int m = 32; m >= 1; m >>= 1) v += __shfl_xor(v, m);
    return v;
}
__device__ __forceinline__ float sigmoidf_(float x) { return __builtin_amdgcn_rcpf(1.0f + __expf(-x)); }

constexpr int BM = 256, BK = 64, HALF = 128, HTB = HALF * BK * 2, STAGE_BYTES = 8 * HTB, NXCD = 8, WGM = 8;
__host__ __device__ __forceinline__ int lds_byte(int r, int c) { const int st = (r >> 4) * 2 + (c >> 5), rr = r & 15, cc = c & 31, ob = rr * 64 + cc * 2; return st * 1024 + (ob ^ (((ob >> 9) & 1) << 5)); }
__host__ __device__ __forceinline__ void stage_rc(int b, int& R, int& C) { const int st = b / 1024, sb = b % 1024, swz = sb ^ (((sb >> 9) & 1) << 5); R = (st >> 1) * 16 + swz / 64; C = (st & 1) * 32 + (swz % 64) / 2; }
__host__ __device__ __forceinline__ int perm32(int rho) { const int n = rho >> 4, i = rho & 15; return 8 * (i >> 2) + 4 * n + (i & 3); }
struct Unit { int pm, pn; };
struct Gemm { const bf16_t* A; const bf16_t* Bt; int M, N, K; };
struct StaticOrder {
    int nM, nN, nwg, G, c, mix;
    __host__ __device__ void init(int M, int N, int G_, int c_, int mix_ = 0) { nM = M / BM; nN = N / BM; nwg = nM * nN; G = G_; c = c_; mix = mix_; }
    __host__ __device__ bool next(int i, Unit& u) const {
        const long L = (long)i * G + c; if (L >= nwg) return false;
        int wgid = (int)L; { const int q = nwg / NXCD, r = nwg % NXCD, xcd = wgid % NXCD, off = wgid / NXCD; wgid = (xcd < r ? xcd * (q + 1) : r * (q + 1) + (xcd - r) * q) + off; }
        const int nig = WGM * nN, gid = wgid / nig, fm = gid * WGM, gsz = (nM - fm) < WGM ? (nM - fm) : WGM;
        u.pm = fm + ((wgid % nig) % gsz); u.pn = (wgid % nig) / gsz;
        if (mix) {
            const int sidx = u.pn;
            u.pn = sidx < 8 ? sidx + 4 : sidx < 12 ? sidx - 8 : sidx < 15 ? sidx : sidx < 21 ? sidx + 3 : sidx == 21 ? 28 : sidx == 22 ? 15 : sidx < 25 ? sidx - 7 : sidx - 1;
        }
        return true;
    }
};

template <class Epi>
__device__ __forceinline__ void gemm_phase(LAS unsigned char* lds, const Gemm g, const StaticOrder& S, const Epi& E) {
    int tid = threadIdx.x; asm volatile("" : "+v"(tid));
    const int wid = __builtin_amdgcn_readfirstlane(tid >> 6), lane = tid & 63, wr = wid >> 2, wc = wid & 3, fr = lane & 15, fq = lane >> 4;
    const int K = g.K, nt = K / BK;
    unsigned voffA[2], voffB[2];
#pragma unroll
    for (int i = 0; i < 2; ++i) { int R, C; stage_rc(tid * 16 + i * 8192, R, C); const int Rb = Epi::PERM ? ((R & ~31) + perm32(R & 31)) : R;
        voffA[i] = (unsigned)(R * K + C) * 2u; voffB[i] = (unsigned)(Rb * K + C) * 2u; }
    const size_t kstep = (size_t)(BK * 2);
    const size_t hstep = (size_t)HALF * K * 2;
    const size_t tstep = 2 * hstep;
    const unsigned ldsw = (unsigned)wid * 1024u;
    const int aoff = lds_byte(wr * 64 + fr, fq * 8), boff = lds_byte(wc * 32 + fr, fq * 8);
#define PG8_SA(b, h) (((b) * 2 + (h)) * HTB)
#define PG8_SB(b, h) ((4 + (b) * 2 + (h)) * HTB)
#define PG8_STAGE(bufoff, gbase, voff) do { _Pragma("unroll") for (int _i = 0; _i < 2; ++_i) \
        __builtin_amdgcn_global_load_lds((const unsigned*)((const char*)(gbase) + (voff)[_i]), (LAS unsigned*)(lds + (bufoff) + ldsw + _i * 8192), 16, 0, 0); } while (0)
#define PG8_LDA(dst, b, h) do { _Pragma("unroll") for (int m = 0; m < 4; ++m) _Pragma("unroll") for (int k = 0; k < 2; ++k) dst[m][k] = *(const LAS bf16x8*)(lds + PG8_SA(b, h) + aoff + m * 2048 + k * 1024); } while (0)
#define PG8_LDB(dst, b, h) do { _Pragma("unroll") for (int n = 0; n < 2; ++n) _Pragma("unroll") for (int k = 0; k < 2; ++k) dst[n][k] = *(const LAS bf16x8*)(lds + PG8_SB(b, h) + boff + n * 2048 + k * 1024); } while (0)
#define PG8_MMA(ai, bj, At, Bt) do { __builtin_amdgcn_s_setprio(1); _Pragma("unroll") for (int m = 0; m < 4; ++m) _Pragma("unroll") for (int n = 0; n < 2; ++n) _Pragma("unroll") for (int k = 0; k < 2; ++k) \
        acc[ai][bj][m][n] = __builtin_amdgcn_mfma_f32_16x16x32_bf16(Bt[n][k], At[m][k], acc[ai][bj][m][n], 0, 0, 0); __builtin_amdgcn_s_setprio(0); } while (0)
#define PG8_WAIT_V(n) asm volatile("s_waitcnt vmcnt(" #n ")" ::: "memory")
#define PG8_WAIT_L(n) asm volatile("s_waitcnt lgkmcnt(" #n ")" ::: "memory")
#define PG8_BAR __builtin_amdgcn_s_barrier()
#define PG8_SCHED __builtin_amdgcn_sched_barrier(0)
    Unit cur, nxt; int ui = 0;
    if (!S.next(0, cur)) return;
    f32x4 acc[2][2][4][2];
#pragma unroll
    for (int a = 0; a < 2; ++a)
#pragma unroll
        for (int b = 0; b < 2; ++b)
#pragma unroll
            for (int m = 0; m < 4; ++m)
#pragma unroll
                for (int n = 0; n < 2; ++n) acc[a][b][m][n] = (f32x4){0.f, 0.f, 0.f, 0.f};
    bf16x8 At[4][2], B0[2][2], B1[2][2];
    const char* cA = (const char*)g.A + (size_t)cur.pm * tstep; const char* cB = (const char*)g.Bt + (size_t)cur.pn * tstep;
    PG8_STAGE(PG8_SB(0, 0), cB, voffB); PG8_STAGE(PG8_SA(0, 0), cA, voffA); PG8_STAGE(PG8_SB(0, 1), cB + hstep, voffB); PG8_STAGE(PG8_SA(0, 1), cA + hstep, voffA);
    if (wr == 1) PG8_BAR;
    PG8_WAIT_V(4); PG8_BAR;
    PG8_STAGE(PG8_SB(1, 0), cB + kstep, voffB); PG8_STAGE(PG8_SA(1, 0), cA + kstep, voffA); PG8_STAGE(PG8_SB(1, 1), cB + hstep + kstep, voffB);
    PG8_WAIT_V(6); PG8_BAR;
    for (;;) {
        const bool has_next = S.next(ui + 1, nxt);
        const char* nA = has_next ? (const char*)g.A + (size_t)nxt.pm * tstep : cA; const char* nB = has_next ? (const char*)g.Bt + (size_t)nxt.pn * tstep : cB;
#pragma unroll 1
        for (int t = 0; t < nt; t += 2) {
            const bool last = (t == nt - 2);
            const char* a1 = cA + (size_t)(t + 1) * kstep;
            const char* a2 = last ? nA : cA + (size_t)(t + 2) * kstep; const char* b2 = last ? nB : cB + (size_t)(t + 2) * kstep;
            const char* a3 = a2 + kstep; const char* b3 = b2 + kstep;
            PG8_LDB(B0, 0, 0); PG8_SCHED; PG8_LDA(At, 0, 0); PG8_STAGE(PG8_SA(1, 1), a1 + hstep, voffA);
            PG8_WAIT_L(8); PG8_BAR; PG8_WAIT_L(0); PG8_MMA(0, 0, At, B0); PG8_BAR; PG8_SCHED;
            PG8_LDB(B1, 0, 1); PG8_STAGE(PG8_SB(0, 0), b2, voffB);
            PG8_BAR; PG8_WAIT_L(0); PG8_MMA(0, 1, At, B1); PG8_BAR;
            PG8_LDA(At, 0, 1); PG8_STAGE(PG8_SA(0, 0), a2, voffA);
            PG8_BAR; PG8_WAIT_L(0); PG8_MMA(1, 0, At, B0); PG8_BAR; PG8_SCHED;
            PG8_STAGE(PG8_SB(0, 1), b2 + hstep, voffB);
            PG8_WAIT_V(6); PG8_BAR; PG8_MMA(1, 1, At, B1); PG8_BAR;
            PG8_LDB(B0, 1, 0); PG8_SCHED; PG8_LDA(At, 1, 0); PG8_STAGE(PG8_SA(0, 1), a2 + hstep, voffA);
            PG8_WAIT_L(8); PG8_BAR; PG8_WAIT_L(0); PG8_MMA(0, 0, At, B0); PG8_BAR; PG8_SCHED;
            PG8_LDB(B1, 1, 1); PG8_STAGE(PG8_SB(1, 0), b3, voffB);
            PG8_BAR; PG8_WAIT_L(0); PG8_MMA(0, 1, At, B1); PG8_BAR;
            PG8_LDA(At, 1, 1); PG8_STAGE(PG8_SA(1, 0), a3, voffA);
            PG8_BAR; PG8_WAIT_L(0); PG8_MMA(1, 0, At, B0); PG8_BAR; PG8_SCHED;
            PG8_STAGE(PG8_SB(1, 1), b3 + hstep, voffB);
            PG8_WAIT_V(6); PG8_BAR; PG8_MMA(1, 1, At, B1); PG8_BAR;
        }
        if constexpr (!Epi::AFTER_DRAIN) E(acc, cur, wr, wc, fr, fq);
        if (!has_next) break;
#pragma unroll
        for (int a = 0; a < 2; ++a)
#pragma unroll
            for (int b = 0; b < 2; ++b)
#pragma unroll
                for (int m = 0; m < 4; ++m)
#pragma unroll
                    for (int n = 0; n < 2; ++n) acc[a][b][m][n] = (f32x4){0.f, 0.f, 0.f, 0.f};
        cur = nxt; cA = nA; cB = nB; ++ui;
    }
    PG8_WAIT_V(0);
    if (wr == 0) PG8_BAR;
    PG8_BAR;
    if constexpr (Epi::AFTER_DRAIN) E.fused(acc, cur, wr, wc, fr, fq, lds);
#undef PG8_SA
#undef PG8_SB
#undef PG8_STAGE
#undef PG8_LDA
#undef PG8_LDB
#undef PG8_MMA
#undef PG8_WAIT_V
#undef PG8_WAIT_L
#undef PG8_BAR
#undef PG8_SCHED
}

struct Epi1 {
    static constexpr bool PERM = true, AFTER_DRAIN = false;
    bf16_t* proj; float* hg; float* glr; const float* hlb;
    __device__ __forceinline__ void operator()(const f32x4 (&acc)[2][2][4][2], const Unit& u, int wr, int wc, int fr, int fq) const {
        asm volatile("" : "+v"(fr), "+v"(fq));
        const int row0 = u.pm * BM + wr * 64 + fr, col0 = u.pn * BM + wc * 32 + 8 * fq, pn = u.pn;
        if (pn >= 4 && pn < 8) {
#pragma unroll
            for (int bj = 0; bj < 2; ++bj) {
                const int c = col0 + bj * HALF - 1024;
                float lb[8];
                { const f32x4 a0 = *(const f32x4*)(hlb + c), a1 = *(const f32x4*)(hlb + c + 4), b0 = *(const f32x4*)(hlb + 1024 + c), b1 = *(const f32x4*)(hlb + 1024 + c + 4);
#pragma unroll
                  for (int j = 0; j < 4; ++j) { lb[j] = __builtin_amdgcn_rcpf(1.0f + __expf(b0[j] - a0[j])); lb[4 + j] = __builtin_amdgcn_rcpf(1.0f + __expf(b1[j] - a1[j])); } }
#pragma unroll
                for (int ai = 0; ai < 2; ++ai)
#pragma unroll
                    for (int m = 0; m < 4; ++m) {
                        const size_t r = (size_t)(row0 + ai * HALF + m * 16);
                        f32x4 o0, o1;
#pragma unroll
                        for (int j = 0; j < 4; ++j) {
                            const float s0 = sigmoidf_(acc[ai][bj][m][0][j]), s1 = sigmoidf_(acc[ai][bj][m][1][j]);
                            o0[j] = lb[j] + (1.0f - lb[j]) * s0; o1[j] = lb[4 + j] + (1.0f - lb[4 + j]) * s1;
                        }
                        *(f32x4*)(hg + r * 1024 + c) = o0; *(f32x4*)(hg + r * 1024 + c + 4) = o1;
                    }
            }
        } else if (pn == 28) {
            if (wc == 0 && fq < 2) {
#pragma unroll
                for (int ai = 0; ai < 2; ++ai)
#pragma unroll
                    for (int m = 0; m < 4; ++m) {
                        const size_t r = (size_t)(row0 + ai * HALF + m * 16);
                        *(f32x4*)(glr + r * 16 + 8 * fq) = acc[ai][0][m][0]; *(f32x4*)(glr + r * 16 + 8 * fq + 4) = acc[ai][0][m][1];
                    }
            }
        } else {
            const bool do_silu = (pn < 4) || (pn >= 12 && pn < 16) || (pn >= 24);
            const float mul = (pn < 4 || pn == 16 || pn == 17) ? QSCALE : 1.0f;
#pragma unroll
            for (int ai = 0; ai < 2; ++ai)
#pragma unroll
                for (int m = 0; m < 4; ++m) {
                    bf16_t* rowp = proj + (size_t)(row0 + ai * HALF + m * 16) * PS + col0;
#pragma unroll
                    for (int bj = 0; bj < 2; ++bj) {
                        f32x4 v0 = acc[ai][bj][m][0], v1 = acc[ai][bj][m][1];
                        if (do_silu) {
#pragma unroll
                            for (int j = 0; j < 4; ++j) { v0[j] = v0[j] * sigmoidf_(v0[j]); v1[j] = v1[j] * sigmoidf_(v1[j]); }
                        }
                        v0 *= mul; v1 *= mul;
                        u32x4 w; w.x = cvt_pk_bf16(v0[0], v0[1]); w.y = cvt_pk_bf16(v0[2], v0[3]); w.z = cvt_pk_bf16(v1[0], v1[1]); w.w = cvt_pk_bf16(v1[2], v1[3]);
                        *(u32x4*)(rowp + bj * HALF) = w;
                    }
                }
        }
    }
};

struct Epi2 {
    static constexpr bool PERM = true, AFTER_DRAIN = false;
    const float* x; bf16_t* hb; float* hss;
    __device__ __forceinline__ void operator()(const f32x4 (&acc)[2][2][4][2], const Unit& u, int wr, int wc, int fr, int fq) const {
        asm volatile("" : "+v"(fr), "+v"(fq));
        const int row0 = u.pm * BM + wr * 64 + fr, col0 = u.pn * BM + wc * 32 + 8 * fq;
#pragma unroll
        for (int ai = 0; ai < 2; ++ai)
#pragma unroll
            for (int m = 0; m < 4; ++m) {
                const size_t r = (size_t)(row0 + ai * HALF + m * 16);
                float s = 0.f;
#pragma unroll
                for (int bj = 0; bj < 2; ++bj) {
                    const int c = col0 + bj * HALF;
                    const size_t o = r * D + c;
                    const f32x4 h0 = *(const f32x4*)(x + o) + acc[ai][bj][m][0], h1 = *(const f32x4*)(x + o + 4) + acc[ai][bj][m][1];
#pragma unroll
                    for (int j = 0; j < 4; ++j) s += h0[j] * h0[j] + h1[j] * h1[j];
                    u32x4 w; w.x = cvt_pk_bf16(h0[0], h0[1]); w.y = cvt_pk_bf16(h0[2], h0[3]); w.z = cvt_pk_bf16(h1[0], h1[1]); w.w = cvt_pk_bf16(h1[2], h1[3]);
                    *(u32x4*)(hb + o) = w;
                }
                s += __shfl_xor(s, 16); s += __shfl_xor(s, 32);
                if (fq == 0) hss[r * 32 + u.pn * 4 + wc] = s;
            }
    }
};

struct Epi3 {
    static constexpr bool PERM = true, AFTER_DRAIN = false;
    bf16_t* e; float* ess;
    __device__ __forceinline__ void operator()(const f32x4 (&acc)[2][2][4][2], const Unit& u, int wr, int wc, int fr, int fq) const {
        asm volatile("" : "+v"(fr), "+v"(fq));
        const int row0 = u.pm * BM + wr * 64 + fr, col0 = u.pn * BM + wc * 32 + 8 * fq;
#pragma unroll
        for (int ai = 0; ai < 2; ++ai)
#pragma unroll
            for (int m = 0; m < 4; ++m) {
                const size_t r = (size_t)(row0 + ai * HALF + m * 16);
                float s = 0.f;
#pragma unroll
                for (int bj = 0; bj < 2; ++bj) {
                    const f32x4 v0 = acc[ai][bj][m][0], v1 = acc[ai][bj][m][1];
#pragma unroll
                    for (int j = 0; j < 4; ++j) s += v0[j] * v0[j] + v1[j] * v1[j];
                    u32x4 w; w.x = cvt_pk_bf16(v0[0], v0[1]); w.y = cvt_pk_bf16(v0[2], v0[3]); w.z = cvt_pk_bf16(v1[0], v1[1]); w.w = cvt_pk_bf16(v1[2], v1[3]);
                    *(u32x4*)(e + r * D + col0 + bj * HALF) = w;
                }
                s += __shfl_xor(s, 16); s += __shfl_xor(s, 32);
                if (fq == 0) ess[r * 32 + u.pn * 4 + wc] = s;
                __builtin_amdgcn_sched_barrier(0);
            }
    }
};

struct Epi4 {
    static constexpr bool PERM = true, AFTER_DRAIN = false;
    const bf16_t* e; const float* gb; const float* pnw; const bf16_t* hbf; float* h; float* h2ss; const LAS float* rsT; StaticOrder S;
    __device__ __forceinline__ void operator()(const f32x4 (&acc)[2][2][4][2], const Unit& u, int wr, int wc, int fr, int fq) const {
        asm volatile("" : "+v"(fr), "+v"(fq));
        const int row0 = u.pm * BM + wr * 64 + fr, col0 = u.pn * BM + wc * 32 + 8 * fq;
        int ord = 0;
#pragma unroll
        for (int i = 1; i < 4; ++i) { Unit t; if (S.next(i, t) && t.pm == u.pm && t.pn == u.pn) ord = i; }
        const LAS float* rs = rsT + (ord * 256 + wr * 64 + fr) * 2;
#pragma unroll
        for (int ai = 0; ai < 2; ++ai)
#pragma unroll
            for (int m = 0; m < 4; ++m) {
                const size_t r = (size_t)(row0 + ai * HALF + m * 16);
                const float rhh = rs[(ai * HALF + m * 16) * 2], ree = rs[(ai * HALF + m * 16) * 2 + 1];
                float s = 0.f;
#pragma unroll
                for (int bj = 0; bj < 2; ++bj) {
                    const int c = col0 + bj * HALF;
                    const size_t o = r * D + c;
                    const f32x4 b0 = *(const f32x4*)(gb + c), b1 = *(const f32x4*)(gb + c + 4), w0 = *(const f32x4*)(pnw + c), w1 = *(const f32x4*)(pnw + c + 4);
                    const u32x4 ev = *(const u32x4*)(e + o);
                    const u32x4 hv = *(const u32x4*)(hbf + o);
                    f32x4 h0, h1;
                    h0[0] = bflo(hv.x); h0[1] = bfhi(hv.x); h0[2] = bflo(hv.y); h0[3] = bfhi(hv.y); h1[0] = bflo(hv.z); h1[1] = bfhi(hv.z); h1[2] = bflo(hv.w); h1[3] = bfhi(hv.w);
                    f32x4 e0, e1;
                    e0[0] = bflo(ev.x); e0[1] = bfhi(ev.x); e0[2] = bflo(ev.y); e0[3] = bfhi(ev.y);
                    e1[0] = bflo(ev.z); e1[1] = bfhi(ev.z); e1[2] = bflo(ev.w); e1[3] = bfhi(ev.w);
#pragma unroll
                    for (int j = 0; j < 4; ++j) {
                        const float g0 = sigmoidf_(acc[ai][bj][m][0][j] * rhh + b0[j]), g1 = sigmoidf_(acc[ai][bj][m][1][j] * rhh + b1[j]);
                        h0[j] += g0 * (e0[j] * ree * w0[j]); h1[j] += g1 * (e1[j] * ree * w1[j]);
                        s += h0[j] * h0[j] + h1[j] * h1[j];
                    }
                    *(f32x4*)(h + o) = h0; *(f32x4*)(h + o + 4) = h1;
                }
                s += __shfl_xor(s, 16); s += __shfl_xor(s, 32);
                if (fq == 0) h2ss[r * 32 + u.pn * 4 + wc] = s;
                __builtin_amdgcn_sched_barrier(0);
            }
    }
};

__device__ __forceinline__ void transpose_tiles(const float* __restrict__ src, bf16_t* __restrict__ dst, const int K, const int N, const int ntn  , const int ntiles, float* tile  , const int first, const int stride, const float* __restrict__ kscale = nullptr) {
    int tid = threadIdx.x; asm volatile("" : "+v"(tid));
    const int nsn = ntn >> 2, nsuper = ntiles >> 2;
    for (int loc = first; loc < nsuper; loc += stride) {
        const int k0 = (loc / nsn) * 64, n0 = (loc % nsn) * 256;
        f32x4 v[8];
#pragma unroll
        for (int i = 0; i < 8; ++i) {
            const int idx = tid + i * 512, kk = idx >> 6, n4 = (idx & 63) * 4;
            v[i] = (f32x4){0.f, 0.f, 0.f, 0.f};
            if (n0 + n4 < N) v[i] = __builtin_nontemporal_load((const f32x4*)(src + (size_t)(k0 + kk) * N + n0 + n4));
        }
#pragma unroll
        for (int i = 0; i < 8; ++i) {
            const int idx = tid + i * 512, kk = idx >> 6, n4 = (idx & 63) * 4;
            float* tp = tile + kk * 257 + n4; tp[0] = v[i][0]; tp[1] = v[i][1]; tp[2] = v[i][2]; tp[3] = v[i][3];
        }
        __syncthreads();
#pragma unroll
        for (int i = 0; i < 4; ++i) {
            const int idx = tid + i * 512, n = idx >> 3, k8 = (idx & 7) * 8;
            float f[8];
#pragma unroll
            for (int j = 0; j < 8; ++j) f[j] = tile[(k8 + j) * 257 + n];
            if (kscale) { const f32x4 s0 = *(const f32x4*)(kscale + k0 + k8), s1 = *(const f32x4*)(kscale + k0 + k8 + 4);
#pragma unroll
                for (int j = 0; j < 4; ++j) { f[j] *= s0[j]; f[4 + j] *= s1[j]; } }
            u32x4 w; w.x = cvt_pk_bf16(f[0], f[1]); w.y = cvt_pk_bf16(f[2], f[3]); w.z = cvt_pk_bf16(f[4], f[5]); w.w = cvt_pk_bf16(f[6], f[7]);
            *(u32x4*)(dst + (size_t)(n0 + n) * K + k0 + k8) = w;
        }
        __syncthreads();
    }
}

__device__ __forceinline__ void phase_prep(const Args& a, unsigned char* lds) {
    int tid = threadIdx.x; asm volatile("" : "+v"(tid));
    const int wid = tid >> 6, lane = tid & 63;
    bf16_t* U = (bf16_t*)(a.ws + WS_U);
    const float* x = a.in[I_X]; const float* nw = a.in[I_NMW];
    for (int rb = blockIdx.x * 8 + wid; rb < T; rb += gridDim.x * 32) {
        f32x4 v[4][8]; float ss[4]; int rr[4];
#pragma unroll
        for (int q = 0; q < 4; ++q) { const int r = rb + q * (int)gridDim.x * 8; rr[q] = r < T ? r : rb; ss[q] = 0.f;
            const f32x4* xr = (const f32x4*)(x + (size_t)rr[q] * D);
#pragma unroll
            for (int i = 0; i < 8; ++i) v[q][i] = __builtin_nontemporal_load(xr + lane + i * 64); }
#pragma unroll
        for (int q = 0; q < 4; ++q) {
#pragma unroll
            for (int i = 0; i < 8; ++i) ss[q] += v[q][i][0] * v[q][i][0] + v[q][i][1] * v[q][i][1] + v[q][i][2] * v[q][i][2] + v[q][i][3] * v[q][i][3];
            ss[q] = rsqrtf(wave_sum(ss[q]) * (1.0f / D) + EPS); }
#pragma unroll
        for (int i = 0; i < 8; ++i) {
            const f32x4 w = ((const f32x4*)nw)[lane + i * 64];
#pragma unroll
            for (int q = 0; q < 4; ++q) {
                if (rb + q * (int)gridDim.x * 8 < T) {
                    u32x2 o; o.x = cvt_pk_bf16(v[q][i][0] * ss[q] * w[0], v[q][i][1] * ss[q] * w[1]); o.y = cvt_pk_bf16(v[q][i][2] * ss[q] * w[2], v[q][i][3] * ss[q] * w[3]);
                    ((u32x2*)(U + (size_t)rr[q] * D))[lane + i * 64] = o; }
            }
        }
    }
    transpose_tiles(a.in[I_WIN], (bf16_t*)(a.ws + WS_WINT), 2048, DIN, 116, 32 * 116, (float*)lds, blockIdx.x, gridDim.x);
}

constexpr int GS_HG = 16384, GS_GL = 32768;
__device__ __forceinline__ size_t gstate_off(int item) { return item < 128 ? (size_t)item * GS_HG : (size_t)128 * GS_HG + (size_t)(item - 128) * GS_GL; }

__device__ __forceinline__ void load_v128(u32x4 (&v)[2], const bf16_t* vsrc, const int tid) {
#pragma unroll
    for (int i = 0; i < 2; ++i) { const int idx = tid + i * 512, t = (idx >> 2) & 63, ch = (idx & 3) + 4 * (idx >> 8);
        v[i] = *(const u32x4*)(vsrc + (size_t)t * PS + ch * 8); }
}
__device__ __forceinline__ void store_vT128(bf16_t* vT, const u32x4 (&v)[2], const int tid) {
#pragma unroll
    for (int i = 0; i < 2; ++i) { const int idx = tid + i * 512, t = (idx >> 2) & 63, ch = (idx & 3) + 4 * (idx >> 8);
        bf16_t* d = vT + ((ch >> 2) * 32 + (ch & 3) * 4) * 72 + t;
        d[0 * 72] = (bf16_t)(v[i].x & 0xffffu); d[1 * 72] = (bf16_t)(v[i].x >> 16); d[2 * 72] = (bf16_t)(v[i].y & 0xffffu); d[3 * 72] = (bf16_t)(v[i].y >> 16);
        d[16 * 72] = (bf16_t)(v[i].z & 0xffffu); d[17 * 72] = (bf16_t)(v[i].z >> 16); d[18 * 72] = (bf16_t)(v[i].w & 0xffffu); d[19 * 72] = (bf16_t)(v[i].w >> 16); }
}
#define LDS_BARRIER() do { asm volatile("s_waitcnt lgkmcnt(0)" ::: "memory"); __builtin_amdgcn_s_barrier(); asm volatile("" ::: "memory"); } while (0)
template <bool OUT>
__device__ __forceinline__ void recur_pass(const Args& a, unsigned char* lds) {
    int tid = threadIdx.x; asm volatile("" : "+v"(tid));
    const int wid = __builtin_amdgcn_readfirstlane(tid >> 6), seg = __builtin_amdgcn_readfirstlane(tid >> 7);
    bf16_t* qs = (bf16_t*)lds;
    bf16_t* ks = (bf16_t*)(lds + 17408);
    bf16_t* khT = (bf16_t*)(lds + 34816);
    bf16_t* vT = (bf16_t*)(lds + 53248);
    bf16_t* sT = (bf16_t*)(lds + 71680);
    bf16_t* as = (bf16_t*)(lds + 106496);
    float* tot = (float*)(lds + 115712);
    float* decs = (float*)(lds + 117760);
    float* ssb = (float*)(lds + 118272);
    float* w2s = (float*)(lds + 118784);
    float* gls = (float*)(lds + 126976);
    float* nws = (float*)(lds + 131072);
    bf16_t* proj = (bf16_t*)(a.ws + WS_PROJ);
    const float* hg = (const float*)(a.ws + WS_HG);
    const float* glr = (const float*)(a.ws + WS_GLR);
    float* decg = (float*)(a.ws + WS_DEC);
    float* gst = a.out;
    bf16_t* ycat = (bf16_t*)(a.ws + WS_U);
    const int dkb = (wid & 3) * 32, nt0 = (wid >> 2) * 4;
    const int tb = wid & 3, ch = wid >> 2;
    for (int item = blockIdx.x; item < 256; item += gridDim.x) {
        const bool gla = item >= 128;
        int ti_ = tid; asm volatile("" : "+v"(ti_));
        const int c0_ = ti_ & 127, fr0_ = ti_ & 15, fq0_ = (ti_ & 63) >> 4;
        const int h = gla ? (item - 128) >> 5 : item >> 4, grp = gla ? (item - 128) & 31 : item & 15;
        const int G = gla ? 4 : 8, ntile = gla ? 2 : 1, chunk0 = grp * G;
        const int qoff = gla ? 4096 + h * 128 : h * 128;
        const int voff = gla ? 5120 + h * 256 : 2048 + h * 128;
        const int zoff = gla ? 6144 + h * 256 : 3072 + h * 128;
        const int yoff = gla ? 1024 + h * 256 : h * 128;
        const int dvtot = gla ? 256 : 128;
        const float* nw = gla ? a.in[I_GNW] + h * 256 : a.in[I_HNW] + h * 128;
        float* gs_item = gst + gstate_off(item);
        f32x4 S[2][2][4];
#pragma unroll
        for (int t = 0; t < 2; ++t)
#pragma unroll
            for (int n = 0; n < 2; ++n)
#pragma unroll
                for (int nt = 0; nt < 4; ++nt) {
                    S[t][n][nt] = (f32x4){0.f, 0.f, 0.f, 0.f};
                    if (OUT && t < ntile) S[t][n][nt] = *(const f32x4*)(gs_item + (size_t)(t * 128 + (nt0 + nt) * 16 + fr0_) * 128 + dkb + 8 * fq0_ + 4 * n);
                }
        float dprod = 1.0f;
        u32x4 qreg[2], kreg[2], vreg[2][2], zreg[2][2]; f32x4 glreg = (f32x4){0.f, 0.f, 0.f, 0.f};
        float g[16];
#define RP_LOAD_QK(T0) do { \
            if (OUT) { _Pragma("unroll") for (int i = 0; i < 2; ++i) { const int idx = tl_ + i * 512, row = idx >> 4, c8 = (idx & 15) * 8; qreg[i] = *(const u32x4*)(proj + (size_t)((T0) + row) * PS + qoff + c8); } } \
            if (gla) { _Pragma("unroll") for (int i = 0; i < 2; ++i) { const int idx = tl_ + i * 512, row = idx >> 4, c8 = (idx & 15) * 8; kreg[i] = *(const u32x4*)(proj + (size_t)((T0) + row) * PS + qoff + 512 + c8); } } } while (0)
#define RP_LOAD_G(T0) do { if (gla) { if (tl_ < 256) glreg = *(const f32x4*)(glr + (size_t)((T0) + (tl_ >> 2)) * 16 + (tl_ & 3) * 4); } else { _Pragma("unroll") for (int i = 0; i < 16; ++i) g[i] = hg[(size_t)((T0) + seg * 16 + i) * 1024 + h * 128 + (tl_ & 127)]; } } while (0)
#define RP_LOAD_V(T0) do { _Pragma("unroll") for (int t = 0; t < 2; ++t) if (t < ntile) load_v128(vreg[t], proj + (size_t)(T0) * PS + voff + t * 128, tl_); } while (0)
#define RP_LOAD_Z(T0) do { if (OUT) { _Pragma("unroll") for (int t = 0; t < 2; ++t) _Pragma("unroll") for (int p = 0; p < 2; ++p) if (t < ntile) \
            zreg[t][p] = *(const u32x4*)(proj + (size_t)((T0) + tb * 16 + (tl_ & 15)) * PS + zoff + t * 128 + ch * 64 + p * 32 + ((tl_ & 63) >> 4) * 8); } } while (0)
        { int tl_ = tid; asm volatile("" : "+v"(tl_)); const int T0 = chunk0 * 64; RP_LOAD_QK(T0); RP_LOAD_G(T0); RP_LOAD_V(T0); }
        float gbias = 0.f;
        if (OUT && ti_ < dvtot) nws[ti_] = nw[ti_];
        if (gla) {
            const float* w2 = a.in[I_GW2];
#pragma unroll
            for (int r = 0; r < 4; ++r) { const int rr = seg * 4 + r; w2s[rr * 128 + c0_] = w2[rr * 512 + h * 128 + c0_]; }
            gbias = a.in[I_GGB][h * 128 + c0_];
        }
        LDS_BARRIER();
        for (int ci = 0; ci < G; ++ci) {
            const int t0 = (chunk0 + ci) * 64, t0n = t0 + 64; const bool more = ci + 1 < G;
            int tl_ = tid; asm volatile("" : "+v"(tl_));
            const int c = tl_ & 127, fr = tl_ & 15, fq = (tl_ & 63) >> 4, prow = 8 * (fr >> 2) + (fr & 3);
            float b[16];
            if (OUT) {
#pragma unroll
                for (int i = 0; i < 2; ++i) { const int idx = tl_ + i * 512, row = idx >> 4, c8 = (idx & 15) * 8; *(u32x4*)(qs + row * 136 + c8) = qreg[i]; }
            }
            if (gla) {
#pragma unroll
                for (int i = 0; i < 2; ++i) { const int idx = tl_ + i * 512, row = idx >> 4, c8 = (idx & 15) * 8; *(u32x4*)(ks + row * 136 + c8) = kreg[i]; }
                if (tl_ < 256) *(f32x4*)(gls + (tl_ >> 2) * 16 + (tl_ & 3) * 4) = glreg;
            }
            if (gla) LDS_BARRIER();
            if (gla && !OUT) {
                float* gt = (float*)sT;
                const int gtb = wid & 3, gch = wid >> 2;
#pragma unroll
                for (int ct = 0; ct < 4; ++ct) {
                    const int col0 = gch * 64 + ct * 16;
                    f32x4 acc = (f32x4){0.f, 0.f, 0.f, 0.f};
#pragma unroll
                    for (int kk = 0; kk < 4; ++kk)
                        acc = __builtin_amdgcn_mfma_f32_16x16x4f32(gls[(gtb * 16 + fr) * 16 + kk * 4 + fq], w2s[(kk * 4 + fq) * 128 + col0 + fr], acc, 0, 0, 0);
#pragma unroll
                    for (int e = 0; e < 4; ++e) gt[(gtb * 16 + 4 * fq + e) * 136 + col0 + fr] = acc[e];
                }
                LDS_BARRIER();
#pragma unroll
                for (int i = 0; i < 16; ++i) {
                    const float sacc = gt[(seg * 16 + i) * 136 + c] + gbias;
                    g[i] = (fminf(sacc, 0.f) - __logf(1.0f + __expf(-fabsf(sacc)))) * (1.0f / 16.0f);
                }
            } else if (gla) {
                float wv[16];
#pragma unroll
                for (int r = 0; r < 16; ++r) wv[r] = w2s[r * 128 + c];
#pragma unroll
                for (int i = 0; i < 16; ++i) {
                    const float* gl = gls + (seg * 16 + i) * 16;
                    float sacc = gbias;
#pragma unroll
                    for (int r4 = 0; r4 < 4; ++r4) { const f32x4 gv = *(const f32x4*)(gl + r4 * 4);
                        sacc += gv[0] * wv[r4 * 4] + gv[1] * wv[r4 * 4 + 1] + gv[2] * wv[r4 * 4 + 2] + gv[3] * wv[r4 * 4 + 3]; }
                    g[i] = (fminf(sacc, 0.f) - __logf(1.0f + __expf(-fabsf(sacc)))) * (1.0f / 16.0f);
                }
            }
            b[0] = g[0];
            if (gla) {
#pragma unroll
                for (int i = 1; i < 16; ++i) b[i] = b[i - 1] + g[i];
            } else {
#pragma unroll
                for (int i = 1; i < 16; ++i) b[i] = b[i - 1] * g[i];
            }
            tot[seg * 128 + c] = b[15];
            LDS_BARRIER();
            float dlast;
            float kv[16];
            if (gla) {
                float pre = 0.f, blast = 0.f;
#pragma unroll
                for (int s4 = 0; s4 < 4; ++s4) { const float tv = tot[s4 * 128 + c]; if (s4 < seg) pre += tv; blast += tv; }
                dlast = __expf(blast);
#pragma unroll
                for (int i = 0; i < 16; ++i) { kv[i] = bf2f(ks[(seg * 16 + i) * 136 + c]); b[i] = __expf(b[i] + pre); }
            } else {
                float pre = 1.f, plast = 1.f;
#pragma unroll
                for (int s4 = 0; s4 < 4; ++s4) { const float tv = tot[s4 * 128 + c]; if (s4 < seg) pre *= tv; plast *= tv; }
                dlast = plast;
#pragma unroll
                for (int i = 0; i < 16; ++i) { kv[i] = 1.0f - g[i]; b[i] *= pre; }
            }
            {
                unsigned kh[8];
#pragma unroll
                for (int i = 0; i < 16; i += 2) {
                    float khv[2];
#pragma unroll
                    for (int e = 0; e < 2; ++e) {
                        const int ii = i + e, tl = seg * 16 + ii;
                        const float eb = b[ii];
                        const float k = kv[ii];
                        const float kinv = k * __builtin_amdgcn_rcpf(eb);
                        if (OUT) {
                            const float q = bf2f(qs[tl * 136 + c]);
                            qs[tl * 136 + c] = f2bf(q * eb);
                            ks[tl * 136 + c] = f2bf(kinv);
                        }
                        khv[e] = kinv * dlast;
                    }
                    kh[i >> 1] = cvt_pk_bf16(khv[0], khv[1]);
                }
                const int cs = (c & ~31) + 16 * ((c >> 2) & 1) + 4 * ((c >> 3) & 3) + (c & 3);
                *(u32x4*)(khT + cs * 72 + seg * 16) = (u32x4){kh[0], kh[1], kh[2], kh[3]};
                *(u32x4*)(khT + cs * 72 + seg * 16 + 8) = (u32x4){kh[4], kh[5], kh[6], kh[7]};
            }
            const float dch = dlast;
            if (seg == 0) decs[c] = dch;
            dprod *= dch;
            LDS_BARRIER();
            RP_LOAD_Z(t0);
            if (OUT) {
#pragma unroll
                for (int rep = 0; rep < 2; ++rep) {
                    const int idx = wid + rep * 8, ti = idx >> 2, tj = idx & 3;
                    f32x4 acc = (f32x4){0.f, 0.f, 0.f, 0.f};
                    if (tj <= ti) {
#pragma unroll
                        for (int kk = 0; kk < 4; ++kk) {
                            const bf16x8 af = *(const bf16x8*)(ks + (tj * 16 + fr) * 136 + kk * 32 + fq * 8);
                            const bf16x8 bf = *(const bf16x8*)(qs + (ti * 16 + fr) * 136 + kk * 32 + fq * 8);
                            acc = __builtin_amdgcn_mfma_f32_16x16x32_bf16(af, bf, acc, 0, 0, 0);
                        }
                    }
                    const int i_ = ti * 16 + fr, j0 = tj * 16 + fq * 4;
                    u32x2 o;
                    o.x = cvt_pk_bf16(j0 + 0 <= i_ ? acc[0] : 0.f, j0 + 1 <= i_ ? acc[1] : 0.f);
                    o.y = cvt_pk_bf16(j0 + 2 <= i_ ? acc[2] : 0.f, j0 + 3 <= i_ ? acc[3] : 0.f);
                    *(u32x2*)(as + i_ * 72 + j0) = o;
                }
            }
            float dsc[2][4];
#pragma unroll
            for (int n = 0; n < 2; ++n)
#pragma unroll
                for (int e = 0; e < 4; ++e) dsc[n][e] = decs[dkb + 8 * fq + 4 * n + e];
            bf16x8 af[2][2];
#pragma unroll
            for (int n = 0; n < 2; ++n)
#pragma unroll
                for (int kk = 0; kk < 2; ++kk) af[n][kk] = *(const bf16x8*)(khT + (dkb + n * 16 + fr) * 72 + kk * 32 + fq * 8);
            f32x4 ao[2][4];
            float ss = 0.f;
#pragma unroll
            for (int t = 0; t < 2; ++t) {
#pragma unroll
                for (int x = 0; x < 4; ++x) ao[t][x] = (f32x4){0.f, 0.f, 0.f, 0.f};
                if (t < ntile) {
                    store_vT128(vT, vreg[t], tl_);
                    if (OUT) {
#pragma unroll
                        for (int nt = 0; nt < 4; ++nt) {
                            u32x4 o; o.x = cvt_pk_bf16(S[t][0][nt][0], S[t][0][nt][1]); o.y = cvt_pk_bf16(S[t][0][nt][2], S[t][0][nt][3]);
                            o.z = cvt_pk_bf16(S[t][1][nt][0], S[t][1][nt][1]); o.w = cvt_pk_bf16(S[t][1][nt][2], S[t][1][nt][3]);
                            *(u32x4*)(sT + ((nt0 + nt) * 16 + fr) * 136 + dkb + 8 * fq) = o;
                        }
                    }
                    LDS_BARRIER();
                    if (OUT) {
                        bf16x8 ba[2], bq[4];
#pragma unroll
                        for (int kk = 0; kk < 2; ++kk) ba[kk] = *(const bf16x8*)(as + (tb * 16 + fr) * 72 + kk * 32 + fq * 8);
#pragma unroll
                        for (int kk = 0; kk < 4; ++kk) bq[kk] = *(const bf16x8*)(qs + (tb * 16 + fr) * 136 + kk * 32 + fq * 8);
#pragma unroll
                        for (int p = 0; p < 2; ++p)
#pragma unroll
                            for (int n = 0; n < 2; ++n) {
                                const int dvr = ch * 64 + p * 32 + n * 16 + fr;
                                f32x4 acc = (f32x4){0.f, 0.f, 0.f, 0.f};
#pragma unroll
                                for (int kk = 0; kk < 2; ++kk) acc = __builtin_amdgcn_mfma_f32_16x16x32_bf16(*(const bf16x8*)(vT + dvr * 72 + kk * 32 + fq * 8), ba[kk], acc, 0, 0, 0);
#pragma unroll
                                for (int kk = 0; kk < 4; ++kk) acc = __builtin_amdgcn_mfma_f32_16x16x32_bf16(*(const bf16x8*)(sT + dvr * 136 + kk * 32 + fq * 8), bq[kk], acc, 0, 0, 0);
                                ao[t][p * 2 + n] = acc;
                                ss += acc[0] * acc[0] + acc[1] * acc[1] + acc[2] * acc[2] + acc[3] * acc[3];
                                __builtin_amdgcn_sched_barrier(0);
                            }
                    }
#pragma unroll
                    for (int nt = 0; nt < 4; ++nt) {
                        const bf16x8 b0 = *(const bf16x8*)(vT + ((nt0 + nt) * 16 + fr) * 72 + fq * 8), b1 = *(const bf16x8*)(vT + ((nt0 + nt) * 16 + fr) * 72 + 32 + fq * 8);
#pragma unroll
                        for (int n = 0; n < 2; ++n) {
                            f32x4 sv = S[t][n][nt];
#pragma unroll
                            for (int e = 0; e < 4; ++e) sv[e] *= dsc[n][e];
                            sv = __builtin_amdgcn_mfma_f32_16x16x32_bf16(af[n][0], b0, sv, 0, 0, 0);
                            sv = __builtin_amdgcn_mfma_f32_16x16x32_bf16(af[n][1], b1, sv, 0, 0, 0);
                            S[t][n][nt] = sv;
                        }
                        __builtin_amdgcn_sched_barrier(0);
                    }
                    if (t + 1 < ntile) LDS_BARRIER();
                }
            }
            if (more) { RP_LOAD_QK(t0n); RP_LOAD_G(t0n); RP_LOAD_V(t0n); }
            if (OUT) {
                ss += __shfl_xor(ss, 16); ss += __shfl_xor(ss, 32);
                if (fq == 0) ssb[ch * 64 + tb * 16 + fr] = ss;
                LDS_BARRIER();
                const float rstd = rsqrtf((ssb[tb * 16 + fr] + ssb[64 + tb * 16 + fr]) / (float)dvtot + EPS);
                const size_t trow = (size_t)(t0 + tb * 16 + fr);
#pragma unroll
                for (int t = 0; t < 2; ++t)
#pragma unroll
                    for (int p = 0; p < 2; ++p) {
                        if (t < ntile) {
                            const int d0 = t * 128 + ch * 64 + p * 32 + fq * 8;
                            const f32x4 w0 = *(const f32x4*)(nws + d0), w1 = *(const f32x4*)(nws + d0 + 4);
                            const u32x4 z = zreg[t][p];
                            const f32x4 x0 = ao[t][p * 2], x1 = ao[t][p * 2 + 1];
                            u32x4 o;
                            o.x = cvt_pk_bf16(x0[0] * rstd * w0[0] * bflo(z.x), x0[1] * rstd * w0[1] * bfhi(z.x));
                            o.y = cvt_pk_bf16(x0[2] * rstd * w0[2] * bflo(z.y), x0[3] * rstd * w0[3] * bfhi(z.y));
                            o.z = cvt_pk_bf16(x1[0] * rstd * w1[0] * bflo(z.z), x1[1] * rstd * w1[1] * bfhi(z.z));
                            o.w = cvt_pk_bf16(x1[2] * rstd * w1[2] * bflo(z.w), x1[3] * rstd * w1[3] * bfhi(z.w));
                            *(u32x4*)(ycat + trow * D + yoff + d0) = o;
                        }
                    }
            }
        }
#undef RP_LOAD_QK
#undef RP_LOAD_G
#undef RP_LOAD_V
#undef RP_LOAD_Z
        if (!OUT) {
            int te_ = tid; asm volatile("" : "+v"(te_));
            const int c0_ = te_ & 127, fr0_ = te_ & 15, fq0_ = (te_ & 63) >> 4;
#pragma unroll
            for (int t = 0; t < 2; ++t)
#pragma unroll
                for (int n = 0; n < 2; ++n)
#pragma unroll
                    for (int nt = 0; nt < 4; ++nt)
                        if (t < ntile) *(f32x4*)(gs_item + (size_t)(t * 128 + (nt0 + nt) * 16 + fr0_) * 128 + dkb + 8 * fq0_ + 4 * n) = S[t][n][nt];
            if (seg == 0) decg[(size_t)item * 128 + c0_] = dprod;
        }
    }
}

__device__ __forceinline__ void recur_scan(const Args& a) {
    float* gst = a.out; const float* decg = (const float*)(a.ws + WS_DEC);
    for (int e2 = blockIdx.x * 512 + threadIdx.x; e2 < 131072; e2 += gridDim.x * 512) {
        const bool gla = e2 >= 65536;
        const int e = (gla ? e2 - 65536 : e2) * 2;
        const int h = gla ? e >> 15 : e >> 14, idx = gla ? e & 32767 : e & 16383, dk = idx & 127;
        const int ng = gla ? 32 : 16, item0 = gla ? 128 + h * 32 : h * 16;
        const size_t gsz = gla ? GS_GL : GS_HG;
        float* p = gst + gstate_off(item0) + idx;
        const float* dp = decg + (size_t)item0 * 128 + dk;
        float s0 = 0.f, s1 = 0.f;
        for (int g0 = 0; g0 < ng; g0 += 8) {
            f32x2 d[8], dc[8];
#pragma unroll
            for (int i = 0; i < 8; ++i) { d[i] = *(const f32x2*)(p + (size_t)(g0 + i) * gsz); dc[i] = *(const f32x2*)(dp + (size_t)(g0 + i) * 128); }
#pragma unroll
            for (int i = 0; i < 8; ++i) {
                *(f32x2*)(p + (size_t)(g0 + i) * gsz) = (f32x2){s0, s1};
                s0 = dc[i][0] * s0 + d[i][0]; s1 = dc[i][1] * s1 + d[i][1];
            }
        }
    }
}

__device__ __forceinline__ void phase_final(const Args& a) {
    const int tid = threadIdx.x, wid = tid >> 6, lane = tid & 63;
    const float* h2ss = (const float*)(a.ws + WS_H2SS); const float* fw = a.in[I_FNW];
    for (int r = blockIdx.x * 8 + wid; r < T; r += gridDim.x * 8) {
        float s = lane < 32 ? h2ss[(size_t)r * 32 + lane] : 0.f;
        s = wave_sum(s);
        const float rstd = rsqrtf(s * (1.0f / D) + EPS);
        f32x4* o = (f32x4*)(a.out + (size_t)r * D);
#pragma unroll
        for (int i = 0; i < 8; ++i) { const f32x4 w = ((const f32x4*)fw)[lane + i * 64]; f32x4 v = o[lane + i * 64]; v = v * rstd * w; o[lane + i * 64] = v; }
    }
}

#define XB_TMO      128
#define XB_XCNT(j)  (256  + 64 * (j))
#define XB_XSUB(j)  (1280 + 64 * (j))
#define XB_XGEN(j)  (2304 + 64 * (j))
#define XB_TOP      3328
#define XB_TOPGEN   3392
#define XCD_BAR_WORDS 3456
#define XB_SPIN_CAP (1u << 18)

__device__ __forceinline__ unsigned xb_ld(unsigned* p)              { return __hip_atomic_load(p, __ATOMIC_RELAXED, __HIP_MEMORY_SCOPE_AGENT); }
__device__ __forceinline__ unsigned xb_add(unsigned* p, unsigned v) { return __hip_atomic_fetch_add(p, v, __ATOMIC_RELAXED, __HIP_MEMORY_SCOPE_AGENT); }
__device__ __forceinline__ unsigned xb_xcc_id() { return (unsigned)__builtin_amdgcn_s_getreg((3 << 11) | 20) & 0xFu; }
#define XB_SPIN(cond, bar) do { unsigned _sp = 0; while (cond) { __builtin_amdgcn_s_sleep(1); \
    if ((++_sp & 255u) == 0u) { if (xb_ld(&(bar)[XB_TMO])) break; if (_sp > XB_SPIN_CAP) { atomicAdd(&(bar)[XB_TMO], 1u); break; } } } } while (0)

struct XcdBarrier {
    unsigned* bar; unsigned x;
    volatile LAS unsigned* st;
};

__device__ __forceinline__ XcdBarrier xcd_barrier_post(unsigned* bar, volatile LAS unsigned* st) {
    XcdBarrier b; b.bar = bar; b.x = xb_xcc_id(); b.st = st;
    if (threadIdx.x == 0) (void)xb_add(&bar[XB_XCNT(b.x)], 1u);
    return b;
}
__device__ __forceinline__ void xcd_barrier_complete(unsigned* bar, unsigned x, unsigned& nloc, unsigned& nx) {
    const unsigned G = gridDim.x * gridDim.y * gridDim.z;
    unsigned sum, cnt, mine, sp = 0u;
    for (;;) {
        sum = 0u; cnt = 0u; mine = 0u;
#pragma unroll
        for (unsigned j = 0; j < 16; ++j) { const unsigned c = xb_ld(&bar[XB_XCNT(j)]); sum += c; cnt += (c > 0u) ? 1u : 0u; mine = (j == x) ? c : mine; }
        if (sum == G) break;
        __builtin_amdgcn_s_sleep(1);
        if ((++sp & 255u) == 0u) { if (xb_ld(&bar[XB_TMO])) break; if (sp > XB_SPIN_CAP) { atomicAdd(&bar[XB_TMO], 1u); break; } }
    }
    nloc = mine > 0u ? mine : 1u; nx = cnt > 0u ? cnt : 1u;
}

__device__ __forceinline__ void xcd_barrier(const XcdBarrier& b) {
    asm volatile("s_waitcnt vmcnt(0)" ::: "memory");
    __syncthreads();
    if (threadIdx.x == 0) {
        unsigned* bar = b.bar;
        __builtin_amdgcn_s_waitcnt(0);
        unsigned nloc = b.st[0], nx = b.st[1];
        if (nloc == 0u) { xcd_barrier_complete(bar, b.x, nloc, nx); b.st[0] = nloc; b.st[1] = nx; }
        const unsigned old = xb_add(&bar[XB_XSUB(b.x)], 1u);
        const unsigned gen = old / nloc;
        if (old + 1u == (gen + 1u) * nloc) {
            __builtin_amdgcn_fence(__ATOMIC_RELEASE, "agent");
            asm volatile("s_waitcnt vmcnt(0)" ::: "memory");
            const unsigned og = xb_add(&bar[XB_TOP], 1u);
            const unsigned tg = og / nx;
            if (og + 1u == (tg + 1u) * nx) xb_add(&bar[XB_TOPGEN], 1u);
            else XB_SPIN(xb_ld(&bar[XB_TOPGEN]) == tg, bar);
            __builtin_amdgcn_fence(__ATOMIC_ACQUIRE, "agent");
            xb_add(&bar[XB_XGEN(b.x)], 1u);
            asm volatile("s_waitcnt vmcnt(0)" ::: "memory");
        } else {
            XB_SPIN(xb_ld(&bar[XB_XGEN(b.x)]) == gen, bar);
            __builtin_amdgcn_fence(__ATOMIC_ACQUIRE, "agent");
            asm volatile("s_waitcnt vmcnt(0)" ::: "memory");
        }
    }
    __syncthreads();
}


struct Epi4F {
    static constexpr bool PERM = true, AFTER_DRAIN = true;
    const bf16_t* e; const float* gb; const float* pnw; const bf16_t* hbf; float* out; const float* fnw; unsigned* xs; unsigned* cnt; unsigned* bar;
    __device__ __forceinline__ void operator()(const f32x4 (&)[2][2][4][2], const Unit&, int, int, int, int) const {}
    __device__ __forceinline__ void fused(f32x4 (&acc)[2][2][4][2], const Unit& u, int wr, int wc, int fr, int fq, LAS unsigned char* lds) const {
        asm volatile("" : "+v"(fr), "+v"(fq));
        const int row0 = u.pm * BM + wr * 64 + fr, col0 = u.pn * BM + wc * 32 + 8 * fq;
        const LAS float* rs = (const LAS float*)(lds + STAGE_BYTES) + (wr * 64 + fr) * 2;
        LAS float* part = (LAS float*)lds;
        LAS float* rstd2 = (LAS float*)(lds + 4096);
#pragma unroll
        for (int ai = 0; ai < 2; ++ai)
#pragma unroll
            for (int m = 0; m < 4; ++m) {
                const size_t r = (size_t)(row0 + ai * HALF + m * 16);
                const float rhh = rs[(ai * HALF + m * 16) * 2], ree = rs[(ai * HALF + m * 16) * 2 + 1];
                float s = 0.f;
#pragma unroll
                for (int bj = 0; bj < 2; ++bj) {
                    const int c = col0 + bj * HALF;
                    const size_t o = r * D + c;
                    const f32x4 b0 = *(const f32x4*)(gb + c), b1 = *(const f32x4*)(gb + c + 4), w0 = *(const f32x4*)(pnw + c), w1 = *(const f32x4*)(pnw + c + 4);
                    const u32x4 ev = *(const u32x4*)(e + o);
                    const u32x4 hv = *(const u32x4*)(hbf + o);
                    f32x4 h0, h1;
                    h0[0] = bflo(hv.x); h0[1] = bfhi(hv.x); h0[2] = bflo(hv.y); h0[3] = bfhi(hv.y); h1[0] = bflo(hv.z); h1[1] = bfhi(hv.z); h1[2] = bflo(hv.w); h1[3] = bfhi(hv.w);
                    f32x4 e0, e1;
                    e0[0] = bflo(ev.x); e0[1] = bfhi(ev.x); e0[2] = bflo(ev.y); e0[3] = bfhi(ev.y);
                    e1[0] = bflo(ev.z); e1[1] = bfhi(ev.z); e1[2] = bflo(ev.w); e1[3] = bfhi(ev.w);
#pragma unroll
                    for (int j = 0; j < 4; ++j) {
                        const float g0 = sigmoidf_(acc[ai][bj][m][0][j] * rhh + b0[j]), g1 = sigmoidf_(acc[ai][bj][m][1][j] * rhh + b1[j]);
                        h0[j] += g0 * (e0[j] * ree * w0[j]); h1[j] += g1 * (e1[j] * ree * w1[j]);
                        s += h0[j] * h0[j] + h1[j] * h1[j];
                    }
                    acc[ai][bj][m][0] = h0; acc[ai][bj][m][1] = h1;
                }
                s += __shfl_xor(s, 16); s += __shfl_xor(s, 32);
                if (fq == 0) part[(wr * 64 + fr + ai * HALF + m * 16) * 4 + wc] = s;
            }
        __syncthreads();
        const int tid = threadIdx.x;
        if (tid < 256) {
            const float sum = (part[tid * 4 + 0] + part[tid * 4 + 1]) + (part[tid * 4 + 2] + part[tid * 4 + 3]);
            __hip_atomic_store(xs + ((size_t)(u.pm * 8 + u.pn) * 256 + tid), __float_as_uint(sum), __ATOMIC_RELAXED, __HIP_MEMORY_SCOPE_AGENT);
        }
        asm volatile("s_waitcnt vmcnt(0)" ::: "memory");
        __syncthreads();
        if (tid == 0) {
            (void)xb_add(cnt + u.pm * 64, 1u);
            XB_SPIN(xb_ld(cnt + u.pm * 64) < 8u, bar);
        }
        __syncthreads();
        if (tid < 256) {
            float sum = 0.f;
#pragma unroll
            for (int k = 0; k < 8; ++k) sum += __uint_as_float(__hip_atomic_load(xs + ((size_t)(u.pm * 8 + k) * 256 + tid), __ATOMIC_RELAXED, __HIP_MEMORY_SCOPE_AGENT));
            rstd2[tid] = rsqrtf(sum * (1.0f / D) + EPS);
        }
        __syncthreads();
#pragma unroll
        for (int ai = 0; ai < 2; ++ai)
#pragma unroll
            for (int m = 0; m < 4; ++m) {
                const size_t r = (size_t)(row0 + ai * HALF + m * 16);
                const float rr = rstd2[wr * 64 + fr + ai * HALF + m * 16];
#pragma unroll
                for (int bj = 0; bj < 2; ++bj) {
                    const int c = col0 + bj * HALF;
                    const f32x4 f0 = *(const f32x4*)(fnw + c), f1 = *(const f32x4*)(fnw + c + 4);
                    *(f32x4*)(out + r * D + c) = acc[ai][bj][m][0] * rr * f0; *(f32x4*)(out + r * D + c + 4) = acc[ai][bj][m][1] * rr * f1;
                }
                __builtin_amdgcn_sched_barrier(0);
            }
    }
};

constexpr int N_PHASES = 8;
#ifndef PHASE_MASK
#define PHASE_MASK 0xff
#endif
#define PH_ON(p) ((PHASE_MASK >> (p)) & 1)
__global__ void __launch_bounds__(512, 2) fwd_kernel(Args a) {
    extern __shared__ __attribute__((aligned(16))) unsigned char lds[];
    cg::grid_group grid = cg::this_grid();
    if (a.ph_lo < 0) grid.sync();
    if (threadIdx.x == 0) { volatile LAS unsigned* st = (volatile LAS unsigned*)(((LAS unsigned char*)lds) + LDS_XB); st[0] = 0u; st[1] = 0u; }
    __syncthreads();
    const XcdBarrier xb = xcd_barrier_post((unsigned*)(a.ws + WS_BAR), (volatile LAS unsigned*)(((LAS unsigned char*)lds) + LDS_XB));
    const bool fuse_final = (gridDim.x == 256) && (a.ph_hi - a.ph_lo == N_PHASES);
#define RUN(p) (PH_ON(p) && a.ph_lo <= (p) && (p) < a.ph_hi)
#define SEAM(p) do { if (a.ph_lo < (p)) xcd_barrier(xb); } while (0)
    {
        if (RUN(0)) {
            phase_prep(a, lds);
        }
        if (RUN(1)) { SEAM(1);
            Gemm g{(const bf16_t*)(a.ws + WS_U), (const bf16_t*)(a.ws + WS_WINT), T, NPAD, D};
            StaticOrder S; S.init(T, NPAD, (int)gridDim.x, (int)blockIdx.x, 1);
            Epi1 E{(bf16_t*)(a.ws + WS_PROJ), (float*)(a.ws + WS_HG), (float*)(a.ws + WS_GLR), a.in[I_HLB]};
            gemm_phase(((LAS unsigned char*)lds), g, S, E);
            {
                const int G = (int)gridDim.x, R = (S.nwg + G - 1) / G; int c0 = S.nwg - (R - 1) * G; if (c0 >= G) c0 = 0;
                if ((int)blockIdx.x >= c0) {
                    transpose_tiles(a.in[I_WOUT], (bf16_t*)(a.ws + WS_WOUTT), 2048, 2048, 32, 32 * 32, (float*)lds, (int)blockIdx.x - c0, G - c0);
                    transpose_tiles(a.in[I_PGW], (bf16_t*)(a.ws + WS_WGT), 2048, 2048, 32, 32 * 32, (float*)lds, (int)blockIdx.x - c0, G - c0, a.in[I_PGNW]);
                    transpose_tiles(a.in[I_PPROJ], (bf16_t*)(a.ws + WS_WPT), 256, 2048, 32, 4 * 32, (float*)lds, (int)blockIdx.x - c0, G - c0);
                    {
                        const f32x4* p4 = (const f32x4*)a.in[I_P]; u32x2* pb = (u32x2*)(a.ws + WS_PB);
                        for (int i = ((int)blockIdx.x - c0) * 512 + (int)threadIdx.x; i < T * 256 / 4; i += (G - c0) * 512) {
                            const f32x4 v = __builtin_nontemporal_load(p4 + i); u32x2 o; o.x = cvt_pk_bf16(v[0], v[1]); o.y = cvt_pk_bf16(v[2], v[3]); pb[i] = o;
                        }
                    }
                }
            }
        }
        if (RUN(2)) { SEAM(2);
            recur_pass<false>(a, lds);
        }
        if (RUN(3)) { SEAM(3);
            recur_scan(a);
        }
        if (RUN(4)) { SEAM(4);
            recur_pass<true>(a, lds);
        }
        if (RUN(5)) { SEAM(5);
            { Gemm g{(const bf16_t*)(a.ws + WS_U), (const bf16_t*)(a.ws + WS_WOUTT), T, D, D};
              StaticOrder S; S.init(T, D, (int)gridDim.x, (int)blockIdx.x);
              Epi2 E{a.in[I_X], (bf16_t*)(a.ws + WS_PROJ), (float*)(a.ws + WS_HSS)};
              gemm_phase(((LAS unsigned char*)lds), g, S, E); }
            { Gemm g{(const bf16_t*)(a.ws + WS_PB), (const bf16_t*)(a.ws + WS_WPT), T, D, 256};
              StaticOrder S; S.init(T, D, (int)gridDim.x, (int)blockIdx.x);
              Epi3 E{(bf16_t*)(a.ws + WS_HG), (float*)(a.ws + WS_ESS)};
              gemm_phase(((LAS unsigned char*)lds), g, S, E); }
        }
        if (RUN(6)) { SEAM(6);
            Gemm g{(const bf16_t*)(a.ws + WS_PROJ), (const bf16_t*)(a.ws + WS_WGT), T, D, D};
            StaticOrder S; S.init(T, D, (int)gridDim.x, (int)blockIdx.x);
            {
                LAS float* rsT = (LAS float*)(((LAS unsigned char*)lds) + STAGE_BYTES);
                const float* hss = (const float*)(a.ws + WS_HSS); const float* ess = (const float*)(a.ws + WS_ESS);
                for (int i = 0; i < 4; ++i) { Unit u; if (!S.next(i, u)) break;
                    const int row = threadIdx.x >> 1, which = threadIdx.x & 1;
                    const float* src = (which ? ess : hss) + (size_t)(u.pm * BM + row) * 32;
                    float sum = 0.f;
#pragma unroll
                    for (int k = 0; k < 8; ++k) { const f32x4 v = *(const f32x4*)(src + 4 * k); sum += (v[0] + v[1]) + (v[2] + v[3]); }
                    rsT[(i * 256 + row) * 2 + which] = rsqrtf(sum * (1.0f / D) + EPS);
                }
                __syncthreads();
            }
            if (fuse_final) {
                Epi4F E{(const bf16_t*)(a.ws + WS_HG), a.in[I_PGB], a.in[I_PNW], (const bf16_t*)(a.ws + WS_PROJ), a.out, a.in[I_FNW], (unsigned*)(a.ws + WS_XS), (unsigned*)(a.ws + WS_CNT), (unsigned*)(a.ws + WS_BAR)};
                gemm_phase(((LAS unsigned char*)lds), g, S, E);
            } else {
                Epi4 E{(const bf16_t*)(a.ws + WS_HG), a.in[I_PGB], a.in[I_PNW], (const bf16_t*)(a.ws + WS_PROJ), a.out, (float*)(a.ws + WS_H2SS), (const LAS float*)(((LAS unsigned char*)lds) + STAGE_BYTES), S};
                gemm_phase(((LAS unsigned char*)lds), g, S, E);
            }
        }
        if (RUN(7) && !fuse_final) { SEAM(7);
            phase_final(a);
        }
    }
}


extern "C" void kernel_launch(void* const* d_in, const int* in_sizes, int n_in, void* d_out, int out_size, void* d_ws, size_t ws_size, hipStream_t stream) {
    static int grid_blocks = 0;
    if (!grid_blocks) {
        int dev = 0, cus = 0, per_cu = 0;
        hipGetDevice(&dev);
        hipDeviceGetAttribute(&cus, hipDeviceAttributeMultiprocessorCount, dev);
        hipFuncSetAttribute((const void*)fwd_kernel, hipFuncAttributeMaxDynamicSharedMemorySize, LDS_BYTES);
        hipOccupancyMaxActiveBlocksPerMultiprocessor(&per_cu, fwd_kernel, 512, LDS_BYTES);
        if (per_cu < 1) { fprintf(stderr, "kernel_launch: occupancy query says %d blocks per CU\n", per_cu); per_cu = 1; }
        grid_blocks = cus * 1;
        if (n_in != 16 || ws_size < WS_END) fprintf(stderr, "kernel_launch: unexpected n_in %d / ws_size %zu (need %zu)\n", n_in, ws_size, (size_t)WS_END);
    }
    Args a{};
    for (int i = 0; i < 16; ++i) a.in[i] = (const float*)d_in[i];
    a.out = (float*)d_out; a.ws = (unsigned char*)d_ws;
#if MK_MULTI
    for (int ph = 0; ph < N_PHASES; ++ph) {
        a.ph_lo = ph; a.ph_hi = ph + 1;
        hipLaunchKernelGGL(fwd_kernel, dim3(grid_blocks), dim3(512), LDS_BYTES, stream, a);
    }
#else
    a.ph_lo = 0; a.ph_hi = N_PHASES;
    hipMemsetAsync((unsigned char*)d_ws + WS_BAR, 0, 16384 + 8192, stream);
    void* kargs[] = {&a};
    hipError_t e = hipLaunchCooperativeKernel((const void*)fwd_kernel, dim3(grid_blocks), dim3(512), kargs, LDS_BYTES, stream);
    if (e != hipSuccess) fprintf(stderr, "cooperative launch failed: %s (grid %d)\n", hipGetErrorString(e), grid_blocks);
#endif
}
```

```cpp
#include <hip/hip_runtime.h>
#include <hip/hip_cooperative_groups.h>
#include <cstdio>
namespace cg = cooperative_groups;

#ifndef MK_MULTI
#define MK_MULTI 0
#endif

#define LAS __attribute__((address_space(3)))
typedef unsigned short bf16_t;
typedef short bf16x8 __attribute__((ext_vector_type(8)));
typedef float f32x4 __attribute__((ext_vector_type(4)));
typedef unsigned u32x4 __attribute__((ext_vector_type(4)));
typedef unsigned u32x2 __attribute__((ext_vector_type(2)));

constexpr int T = 8192, D = 2048, DIN = 7184, NPAD = 7424, PS = 7168  ;
constexpr int NCHUNK = 128, NITEM = NCHUNK * 12, SELEM = 262144;
constexpr float EPS = 1e-6f;
constexpr float QSCALE = 0.08838834764831845f;

constexpr size_t WS_U = 0;
constexpr size_t WS_WINT = WS_U + (size_t)T * D * 2;
constexpr size_t WS_PB = WS_WINT + (size_t)NPAD * D * 2;
constexpr size_t WS_WPT = WS_PB + (size_t)T * 256 * 2;
constexpr size_t WS_WOUTT = WS_WPT + (size_t)D * 256 * 2;
constexpr size_t WS_WGT = WS_WOUTT + (size_t)D * D * 2;
constexpr size_t WS_PROJ = WS_WGT + (size_t)D * D * 2;
constexpr size_t WS_HG = WS_PROJ + (size_t)T * PS * 2;
constexpr size_t WS_GLR = WS_HG + (size_t)T * 1024 * 4;
constexpr size_t WS_DEC = WS_GLR + (size_t)T * 16 * 4;
constexpr size_t WS_HSS = WS_DEC + (size_t)NCHUNK * 12 * 128 * 4;
constexpr size_t WS_ESS = WS_HSS + (size_t)T * 32 * 4;
constexpr size_t WS_H2SS = WS_ESS + (size_t)T * 32 * 4;
constexpr size_t WS_END = WS_H2SS + (size_t)T * 32 * 4;
constexpr size_t WS_BAR = (WS_END + 255) & ~(size_t)255;
constexpr size_t WS_CNT = WS_BAR + 16384;
constexpr size_t WS_XS = WS_CNT + 8192;
constexpr int LDS_XB = 139264;
constexpr int LDS_BYTES = 140 * 1024;

struct Args { const float* in[16]; float* out; unsigned char* ws; int ph_lo, ph_hi; };
enum { I_X = 0, I_P, I_NMW, I_WIN, I_HLB, I_GW2, I_GGB, I_HNW, I_GNW, I_WOUT, I_PPROJ, I_PNW, I_PGNW, I_PGW, I_PGB, I_FNW };

typedef __bf16 bf16v2 __attribute__((ext_vector_type(2)));
typedef float f32x2 __attribute__((ext_vector_type(2)));
__device__ __forceinline__ unsigned cvt_pk_bf16(float lo, float hi) { const f32x2 v = {lo, hi}; const bf16v2 b = __builtin_convertvector(v, bf16v2); return __builtin_bit_cast(unsigned, b); }
__device__ __forceinline__ bf16_t f2bf(float f) { return (bf16_t)(cvt_pk_bf16(f, 0.f) & 0xffffu); }
__device__ __forceinline__ float bf2f(unsigned b) { return __uint_as_float(b << 16); }
__device__ __forceinline__ float bflo(unsigned w) { return __uint_as_float(w << 16); }
__device__ __forceinline__ float bfhi(unsigned w) { return __uint_as_float(w & 0xffff0000u); }
__device__ __forceinline__ float wave_sum(float v) {
#pragma unroll
    for (int m = 32; m >= 1; m >>= 1) v += __shfl_xor(v, m);
    return v;
}
__device__ __forceinline__ float sigmoidf_(float x) { return __builtin_amdgcn_rcpf(1.0f + __expf(-x)); }

constexpr int BM = 256, BK = 64, HALF = 128, HTB = HALF * BK * 2, STAGE_BYTES = 8 * HTB, NXCD = 8, WGM = 8;
__host__ __device__ __forceinline__ int lds_byte(int r, int c) { const int st = (r >> 4) * 2 + (c >> 5), rr = r & 15, cc = c & 31, ob = rr * 64 + cc * 2; return st * 1024 + (ob ^ (((ob >> 9) & 1) << 5)); }
__host__ __device__ __forceinline__ void stage_rc(int b, int& R, int& C) { const int st = b / 1024, sb = b % 1024, swz = sb ^ (((sb >> 9) & 1) << 5); R = (st >> 1) * 16 + swz / 64; C = (st & 1) * 32 + (swz % 64) / 2; }
__host__ __device__ __forceinline__ int perm32(int rho) { const int n = rho >> 4, i = rho & 15; return 8 * (i >> 2) + 4 * n + (i & 3); }
struct Unit { int pm, pn; };
struct Gemm { const bf16_t* A; const bf16_t* Bt; int M, N, K; };
struct StaticOrder {
    int nM, nN, nwg, G, c, mix;
    __host__ __device__ void init(int M, int N, int G_, int c_, int mix_ = 0) { nM = M / BM; nN = N / BM; nwg = nM * nN; G = G_; c = c_; mix = mix_; }
    __host__ __device__ bool next(int i, Unit& u) const {
        const long L = (long)i * G + c; if (L >= nwg) return false;
        int wgid = (int)L; { const int q = nwg / NXCD, r = nwg % NXCD, xcd = wgid % NXCD, off = wgid / NXCD; wgid = (xcd < r ? xcd * (q + 1) : r * (q + 1) + (xcd - r) * q) + off; }
        const int nig = WGM * nN, gid = wgid / nig, fm = gid * WGM, gsz = (nM - fm) < WGM ? (nM - fm) : WGM;
        u.pm = fm + ((wgid % nig) % gsz); u.pn = (wgid % nig) / gsz;
        if (mix) {
            const int sidx = u.pn;
            u.pn = sidx < 8 ? sidx + 4 : sidx < 12 ? sidx - 8 : sidx < 15 ? sidx : sidx < 21 ? sidx + 3 : sidx == 21 ? 28 : sidx == 22 ? 15 : sidx < 25 ? sidx - 7 : sidx - 1;
        }
        return true;
    }
};

template <class Epi>
__device__ __forceinline__ void gemm_phase(LAS unsigned char* lds, const Gemm g, const StaticOrder& S, const Epi& E) {
    int tid = threadIdx.x; asm volatile("" : "+v"(tid));
    const int wid = __builtin_amdgcn_readfirstlane(tid >> 6), lane = tid & 63, wr = wid >> 2, wc = wid & 3, fr = lane & 15, fq = lane >> 4;
    const int K = g.K, nt = K / BK;
    unsigned voffA[2], voffB[2];
#pragma unroll
    for (int i = 0; i < 2; ++i) { int R, C; stage_rc(tid * 16 + i * 8192, R, C); const int Rb = Epi::PERM ? ((R & ~31) + perm32(R & 31)) : R;
        voffA[i] = (unsigned)(R * K + C) * 2u; voffB[i] = (unsigned)(Rb * K + C) * 2u; }
    const size_t kstep = (size_t)(BK * 2);
    const size_t hstep = (size_t)HALF * K * 2;
    const size_t tstep = 2 * hstep;
    const unsigned ldsw = (unsigned)wid * 1024u;
    const int aoff = lds_byte(wr * 64 + fr, fq * 8), boff = lds_byte(wc * 32 + fr, fq * 8);
#define PG8_SA(b, h) (((b) * 2 + (h)) * HTB)
#define PG8_SB(b, h) ((4 + (b) * 2 + (h)) * HTB)
#define PG8_STAGE(bufoff, gbase, voff) do { _Pragma("unroll") for (int _i = 0; _i < 2; ++_i) \
        __builtin_amdgcn_global_load_lds((const unsigned*)((const char*)(gbase) + (voff)[_i]), (LAS unsigned*)(lds + (bufoff) + ldsw + _i * 8192), 16, 0, 0); } while (0)
#define PG8_LDA(dst, b, h) do { _Pragma("unroll") for (int m = 0; m < 4; ++m) _Pragma("unroll") for (int k = 0; k < 2; ++k) dst[m][k] = *(const LAS bf16x8*)(lds + PG8_SA(b, h) + aoff + m * 2048 + k * 1024); } while (0)
#define PG8_LDB(dst, b, h) do { _Pragma("unroll") for (int n = 0; n < 2; ++n) _Pragma("unroll") for (int k = 0; k < 2; ++k) dst[n][k] = *(const LAS bf16x8*)(lds + PG8_SB(b, h) + boff + n * 2048 + k * 1024); } while (0)
#define PG8_MMA(ai, bj, At, Bt) do { __builtin_amdgcn_s_setprio(1); _Pragma("unroll") for (int m = 0; m < 4; ++m) _Pragma("unroll") for (int n = 0; n < 2; ++n) _Pragma("unroll") for (int k = 0; k < 2; ++k) \
        acc[ai][bj][m][n] = __builtin_amdgcn_mfma_f32_16x16x32_bf16(Bt[n][k], At[m][k], acc[ai][bj][m][n], 0, 0, 0); __builtin_amdgcn_s_setprio(0); } while (0)
#define PG8_WAIT_V(n) asm volatile("s_waitcnt vmcnt(" #n ")" ::: "memory")
#define PG8_WAIT_L(n) asm volatile("s_waitcnt lgkmcnt(" #n ")" ::: "memory")
#define PG8_BAR __builtin_amdgcn_s_barrier()
#define PG8_SCHED __builtin_amdgcn_sched_barrier(0)
    Unit cur, nxt; int ui = 0;
    if (!S.next(0, cur)) return;
    f32x4 acc[2][2][4][2];
#pragma unroll
    for (int a = 0; a < 2; ++a)
#pragma unroll
        for (int b = 0; b < 2; ++b)
#pragma unroll
            for (int m = 0; m < 4; ++m)
#pragma unroll
                for (int n = 0; n < 2; ++n) acc[a][b][m][n] = (f32x4){0.f, 0.f, 0.f, 0.f};
    bf16x8 At[4][2], B0[2][2], B1[2][2];
    const char* cA = (const char*)g.A + (size_t)cur.pm * tstep; const char* cB = (const char*)g.Bt + (size_t)cur.pn * tstep;
    PG8_STAGE(PG8_SB(0, 0), cB, voffB); PG8_STAGE(PG8_SA(0, 0), cA, voffA); PG8_STAGE(PG8_SB(0, 1), cB + hstep, voffB); PG8_STAGE(PG8_SA(0, 1), cA + hstep, voffA);
    if (wr == 1) PG8_BAR;
    PG8_WAIT_V(4); PG8_BAR;
    PG8_STAGE(PG8_SB(1, 0), cB + kstep, voffB); PG8_STAGE(PG8_SA(1, 0), cA + kstep, voffA); PG8_STAGE(PG8_SB(1, 1), cB + hstep + kstep, voffB);
    PG8_WAIT_V(6); PG8_BAR;
    for (;;) {
        const bool has_next = S.next(ui + 1, nxt);
        const char* nA = has_next ? (const char*)g.A + (size_t)nxt.pm * tstep : cA; const char* nB = has_next ? (const char*)g.Bt + (size_t)nxt.pn * tstep : cB;
#pragma unroll 1
        for (int t = 0; t < nt; t += 2) {
            const bool last = (t == nt - 2);
            const char* a1 = cA + (size_t)(t + 1) * kstep;
            const char* a2 = last ? nA : cA + (size_t)(t + 2) * kstep; const char* b2 = last ? nB : cB + (size_t)(t + 2) * kstep;
            const char* a3 = a2 + kstep; const char* b3 = b2 + kstep;
            PG8_LDB(B0, 0, 0); PG8_SCHED; PG8_LDA(At, 0, 0); PG8_STAGE(PG8_SA(1, 1), a1 + hstep, voffA);
            PG8_WAIT_L(8); PG8_BAR; PG8_WAIT_L(0); PG8_MMA(0, 0, At, B0); PG8_BAR; PG8_SCHED;
            PG8_LDB(B1, 0, 1); PG8_STAGE(PG8_SB(0, 0), b2, voffB);
            PG8_BAR; PG8_WAIT_L(0); PG8_MMA(0, 1, At, B1); PG8_BAR;
            PG8_LDA(At, 0, 1); PG8_STAGE(PG8_SA(0, 0), a2, voffA);
            PG8_BAR; PG8_WAIT_L(0); PG8_MMA(1, 0, At, B0); PG8_BAR; PG8_SCHED;
            PG8_STAGE(PG8_SB(0, 1), b2 + hstep, voffB);
            PG8_WAIT_V(6); PG8_BAR; PG8_MMA(1, 1, At, B1); PG8_BAR;
            PG8_LDB(B0, 1, 0); PG8_SCHED; PG8_LDA(At, 1, 0); PG8_STAGE(PG8_SA(0, 1), a2 + hstep, voffA);
            PG8_WAIT_L(8); PG8_BAR; PG8_WAIT_L(0); PG8_MMA(0, 0, At, B0); PG8_BAR; PG8_SCHED;
            PG8_LDB(B1, 1, 1); PG8_STAGE(PG8_SB(1, 0), b3, voffB);
            PG8_BAR; PG8_WAIT_L(0); PG8_MMA(0, 1, At, B1); PG8_BAR;
            PG8_LDA(At, 1, 1); PG8_STAGE(PG8_SA(1, 0), a3, voffA);
            PG8_BAR; PG8_WAIT_L(0); PG8_MMA(1, 0, At, B0); PG8_BAR; PG8_SCHED;
            PG8_STAGE(PG8_SB(1, 1), b3 + hstep, voffB);
            PG8_WAIT_V(6); PG8_BAR; PG8_MMA(1, 1, At, B1); PG8_BAR;
        }
        if constexpr (!Epi::AFTER_DRAIN) E(acc, cur, wr, wc, fr, fq);
        if (!has_next) break;
#pragma unroll
        for (int a = 0; a < 2; ++a)
#pragma unroll
            for (int b = 0; b < 2; ++b)
#pragma unroll
                for (int m = 0; m < 4; ++m)
#pragma unroll
                    for (int n = 0; n < 2; ++n) acc[a][b][m][n] = (f32x4){0.f, 0.f, 0.f, 0.f};
        cur = nxt; cA = nA; cB = nB; ++ui;
    }
    PG8_WAIT_V(0);
    if (wr == 0) PG8_BAR;
    PG8_BAR;
    if constexpr (Epi::AFTER_DRAIN) E.fused(acc, cur, wr, wc, fr, fq, lds);
#undef PG8_SA
#undef PG8_SB
#undef PG8_STAGE
#undef PG8_LDA
#undef PG8_LDB
#undef PG8_MMA
#undef PG8_WAIT_V
#undef PG8_WAIT_L
#undef PG8_BAR
#undef PG8_SCHED
}

struct Epi1 {
    static constexpr bool PERM = true, AFTER_DRAIN = false;
    bf16_t* proj; float* hg; float* glr; const float* hlb;
    __device__ __forceinline__ void operator()(const f32x4 (&acc)[2][2][4][2], const Unit& u, int wr, int wc, int fr, int fq) const {
        asm volatile("" : "+v"(fr), "+v"(fq));
        const int row0 = u.pm * BM + wr * 64 + fr, col0 = u.pn * BM + wc * 32 + 8 * fq, pn = u.pn;
        if (pn >= 4 && pn < 8) {
#pragma unroll
            for (int bj = 0; bj < 2; ++bj) {
                const int c = col0 + bj * HALF - 1024;
                float lb[8];
                { const f32x4 a0 = *(const f32x4*)(hlb + c), a1 = *(const f32x4*)(hlb + c + 4), b0 = *(const f32x4*)(hlb + 1024 + c), b1 = *(const f32x4*)(hlb + 1024 + c + 4);
#pragma unroll
                  for (int j = 0; j < 4; ++j) { lb[j] = __builtin_amdgcn_rcpf(1.0f + __expf(b0[j] - a0[j])); lb[4 + j] = __builtin_amdgcn_rcpf(1.0f + __expf(b1[j] - a1[j])); } }
#pragma unroll
                for (int ai = 0; ai < 2; ++ai)
#pragma unroll
                    for (int m = 0; m < 4; ++m) {
                        const size_t r = (size_t)(row0 + ai * HALF + m * 16);
                        f32x4 o0, o1;
#pragma unroll
                        for (int j = 0; j < 4; ++j) {
                            const float s0 = sigmoidf_(acc[ai][bj][m][0][j]), s1 = sigmoidf_(acc[ai][bj][m][1][j]);
                            o0[j] = lb[j] + (1.0f - lb[j]) * s0; o1[j] = lb[4 + j] + (1.0f - lb[4 + j]) * s1;
                        }
                        *(f32x4*)(hg + r * 1024 + c) = o0; *(f32x4*)(hg + r * 1024 + c + 4) = o1;
                    }
            }
        } else if (pn == 28) {
            if (wc == 0 && fq < 2) {
#pragma unroll
                for (int ai = 0; ai < 2; ++ai)
#pragma unroll
                    for (int m = 0; m < 4; ++m) {
                        const size_t r = (size_t)(row0 + ai * HALF + m * 16);
                        *(f32x4*)(glr + r * 16 + 8 * fq) = acc[ai][0][m][0]; *(f32x4*)(glr + r * 16 + 8 * fq + 4) = acc[ai][0][m][1];
                    }
            }
        } else {
            const bool do_silu = (pn < 4) || (pn >= 12 && pn < 16) || (pn >= 24);
            const float mul = (pn < 4 || pn == 16 || pn == 17) ? QSCALE : 1.0f;
#pragma unroll
            for (int ai = 0; ai < 2; ++ai)
#pragma unroll
                for (int m = 0; m < 4; ++m) {
                    bf16_t* rowp = proj + (size_t)(row0 + ai * HALF + m * 16) * PS + col0;
#pragma unroll
                    for (int bj = 0; bj < 2; ++bj) {
                        f32x4 v0 = acc[ai][bj][m][0], v1 = acc[ai][bj][m][1];
                        if (do_silu) {
#pragma unroll
                            for (int j = 0; j < 4; ++j) { v0[j] = v0[j] * sigmoidf_(v0[j]); v1[j] = v1[j] * sigmoidf_(v1[j]); }
                        }
                        v0 *= mul; v1 *= mul;
                        u32x4 w; w.x = cvt_pk_bf16(v0[0], v0[1]); w.y = cvt_pk_bf16(v0[2], v0[3]); w.z = cvt_pk_bf16(v1[0], v1[1]); w.w = cvt_pk_bf16(v1[2], v1[3]);
                        *(u32x4*)(rowp + bj * HALF) = w;
                    }
                }
        }
    }
};

struct Epi2 {
    static constexpr bool PERM = true, AFTER_DRAIN = false;
    const float* x; bf16_t* hb; float* hss;
    __device__ __forceinline__ void operator()(const f32x4 (&acc)[2][2][4][2], const Unit& u, int wr, int wc, int fr, int fq) const {
        asm volatile("" : "+v"(fr), "+v"(fq));
        const int row0 = u.pm * BM + wr * 64 + fr, col0 = u.pn * BM + wc * 32 + 8 * fq;
#pragma unroll
        for (int ai = 0; ai < 2; ++ai)
#pragma unroll
            for (int m = 0; m < 4; ++m) {
                const size_t r = (size_t)(row0 + ai * HALF + m * 16);
                float s = 0.f;
#pragma unroll
                for (int bj = 0; bj < 2; ++bj) {
                    const int c = col0 + bj * HALF;
                    const size_t o = r * D + c;
                    const f32x4 h0 = __builtin_nontemporal_load((const f32x4*)(x + o)) + acc[ai][bj][m][0], h1 = __builtin_nontemporal_load((const f32x4*)(x + o + 4)) + acc[ai][bj][m][1];
#pragma unroll
                    for (int j = 0; j < 4; ++j) s += h0[j] * h0[j] + h1[j] * h1[j];
                    u32x4 w; w.x = cvt_pk_bf16(h0[0], h0[1]); w.y = cvt_pk_bf16(h0[2], h0[3]); w.z = cvt_pk_bf16(h1[0], h1[1]); w.w = cvt_pk_bf16(h1[2], h1[3]);
                    *(u32x4*)(hb + o) = w;
                }
                s += __shfl_xor(s, 16); s += __shfl_xor(s, 32);
                if (fq == 0) hss[r * 32 + u.pn * 4 + wc] = s;
            }
    }
};

struct Epi3 {
    static constexpr bool PERM = true, AFTER_DRAIN = false;
    bf16_t* e; float* ess;
    __device__ __forceinline__ void operator()(const f32x4 (&acc)[2][2][4][2], const Unit& u, int wr, int wc, int fr, int fq) const {
        asm volatile("" : "+v"(fr), "+v"(fq));
        const int row0 = u.pm * BM + wr * 64 + fr, col0 = u.pn * BM + wc * 32 + 8 * fq;
#pragma unroll
        for (int ai = 0; ai < 2; ++ai)
#pragma unroll
            for (int m = 0; m < 4; ++m) {
                const size_t r = (size_t)(row0 + ai * HALF + m * 16);
                float s = 0.f;
#pragma unroll
                for (int bj = 0; bj < 2; ++bj) {
                    const f32x4 v0 = acc[ai][bj][m][0], v1 = acc[ai][bj][m][1];
#pragma unroll
                    for (int j = 0; j < 4; ++j) s += v0[j] * v0[j] + v1[j] * v1[j];
                    u32x4 w; w.x = cvt_pk_bf16(v0[0], v0[1]); w.y = cvt_pk_bf16(v0[2], v0[3]); w.z = cvt_pk_bf16(v1[0], v1[1]); w.w = cvt_pk_bf16(v1[2], v1[3]);
                    *(u32x4*)(e + r * D + col0 + bj * HALF) = w;
                }
                s += __shfl_xor(s, 16); s += __shfl_xor(s, 32);
                if (fq == 0) ess[r * 32 + u.pn * 4 + wc] = s;
                __builtin_amdgcn_sched_barrier(0);
            }
    }
};

struct Epi4 {
    static constexpr bool PERM = true, AFTER_DRAIN = false;
    const bf16_t* e; const float* gb; const float* pnw; const bf16_t* hbf; float* h; float* h2ss; const LAS float* rsT; StaticOrder S;
    __device__ __forceinline__ void operator()(const f32x4 (&acc)[2][2][4][2], const Unit& u, int wr, int wc, int fr, int fq) const {
        asm volatile("" : "+v"(fr), "+v"(fq));
        const int row0 = u.pm * BM + wr * 64 + fr, col0 = u.pn * BM + wc * 32 + 8 * fq;
        int ord = 0;
#pragma unroll
        for (int i = 1; i < 4; ++i) { Unit t; if (S.next(i, t) && t.pm == u.pm && t.pn == u.pn) ord = i; }
        const LAS float* rs = rsT + (ord * 256 + wr * 64 + fr) * 2;
#pragma unroll
        for (int ai = 0; ai < 2; ++ai)
#pragma unroll
            for (int m = 0; m < 4; ++m) {
                const size_t r = (size_t)(row0 + ai * HALF + m * 16);
                const float rhh = rs[(ai * HALF + m * 16) * 2], ree = rs[(ai * HALF + m * 16) * 2 + 1];
                float s = 0.f;
#pragma unroll
                for (int bj = 0; bj < 2; ++bj) {
                    const int c = col0 + bj * HALF;
                    const size_t o = r * D + c;
                    const f32x4 b0 = *(const f32x4*)(gb + c), b1 = *(const f32x4*)(gb + c + 4), w0 = *(const f32x4*)(pnw + c), w1 = *(const f32x4*)(pnw + c + 4);
                    const u32x4 ev = *(const u32x4*)(e + o);
                    const u32x4 hv = *(const u32x4*)(hbf + o);
                    f32x4 h0, h1;
                    h0[0] = bflo(hv.x); h0[1] = bfhi(hv.x); h0[2] = bflo(hv.y); h0[3] = bfhi(hv.y); h1[0] = bflo(hv.z); h1[1] = bfhi(hv.z); h1[2] = bflo(hv.w); h1[3] = bfhi(hv.w);
                    f32x4 e0, e1;
                    e0[0] = bflo(ev.x); e0[1] = bfhi(ev.x); e0[2] = bflo(ev.y); e0[3] = bfhi(ev.y);
                    e1[0] = bflo(ev.z); e1[1] = bfhi(ev.z); e1[2] = bflo(ev.w); e1[3] = bfhi(ev.w);
#pragma unroll
                    for (int j = 0; j < 4; ++j) {
                        const float g0 = sigmoidf_(acc[ai][bj][m][0][j] * rhh + b0[j]), g1 = sigmoidf_(acc[ai][bj][m][1][j] * rhh + b1[j]);
                        h0[j] += g0 * (e0[j] * ree * w0[j]); h1[j] += g1 * (e1[j] * ree * w1[j]);
                        s += h0[j] * h0[j] + h1[j] * h1[j];
                    }
                    *(f32x4*)(h + o) = h0; *(f32x4*)(h + o + 4) = h1;
                }
                s += __shfl_xor(s, 16); s += __shfl_xor(s, 32);
                if (fq == 0) h2ss[r * 32 + u.pn * 4 + wc] = s;
                __builtin_amdgcn_sched_barrier(0);
            }
    }
};

__device__ __forceinline__ void transpose_tiles(const float* __restrict__ src, bf16_t* __restrict__ dst, const int K, const int N, const int ntn  , const int ntiles, float* tile  , const int first, const int stride, const float* __restrict__ kscale = nullptr) {
    int tid = threadIdx.x; asm volatile("" : "+v"(tid));
    const int nsn = ntn >> 2, nsuper = ntiles >> 2;
    for (int loc = first; loc < nsuper; loc += stride) {
        const int k0 = (loc / nsn) * 64, n0 = (loc % nsn) * 256;
        f32x4 v[8];
#pragma unroll
        for (int i = 0; i < 8; ++i) {
            const int idx = tid + i * 512, kk = idx >> 6, n4 = (idx & 63) * 4;
            v[i] = (f32x4){0.f, 0.f, 0.f, 0.f};
            if (n0 + n4 < N) v[i] = __builtin_nontemporal_load((const f32x4*)(src + (size_t)(k0 + kk) * N + n0 + n4));
        }
#pragma unroll
        for (int i = 0; i < 8; ++i) {
            const int idx = tid + i * 512, kk = idx >> 6, n4 = (idx & 63) * 4;
            float* tp = tile + kk * 257 + n4; tp[0] = v[i][0]; tp[1] = v[i][1]; tp[2] = v[i][2]; tp[3] = v[i][3];
        }
        __syncthreads();
#pragma unroll
        for (int i = 0; i < 4; ++i) {
            const int idx = tid + i * 512, n = idx >> 3, k8 = (idx & 7) * 8;
            float f[8];
#pragma unroll
            for (int j = 0; j < 8; ++j) f[j] = tile[(k8 + j) * 257 + n];
            if (kscale) { const f32x4 s0 = *(const f32x4*)(kscale + k0 + k8), s1 = *(const f32x4*)(kscale + k0 + k8 + 4);
#pragma unroll
                for (int j = 0; j < 4; ++j) { f[j] *= s0[j]; f[4 + j] *= s1[j]; } }
            u32x4 w; w.x = cvt_pk_bf16(f[0], f[1]); w.y = cvt_pk_bf16(f[2], f[3]); w.z = cvt_pk_bf16(f[4], f[5]); w.w = cvt_pk_bf16(f[6], f[7]);
            *(u32x4*)(dst + (size_t)(n0 + n) * K + k0 + k8) = w;
        }
        __syncthreads();
    }
}

__device__ __forceinline__ void phase_prep(const Args& a, unsigned char* lds) {
    int tid = threadIdx.x; asm volatile("" : "+v"(tid));
    const int wid = tid >> 6, lane = tid & 63;
    bf16_t* U = (bf16_t*)(a.ws + WS_U);
    const float* x = a.in[I_X]; const float* nw = a.in[I_NMW];
    for (int rb = blockIdx.x * 8 + wid; rb < T; rb += gridDim.x * 32) {
        f32x4 v[4][8]; float ss[4]; int rr[4];
#pragma unroll
        for (int q = 0; q < 4; ++q) { const int r = rb + q * (int)gridDim.x * 8; rr[q] = r < T ? r : rb; ss[q] = 0.f;
            const f32x4* xr = (const f32x4*)(x + (size_t)rr[q] * D);
#pragma unroll
            for (int i = 0; i < 8; ++i) v[q][i] = __builtin_nontemporal_load(xr + lane + i * 64); }
#pragma unroll
        for (int q = 0; q < 4; ++q) {
#pragma unroll
            for (int i = 0; i < 8; ++i) ss[q] += v[q][i][0] * v[q][i][0] + v[q][i][1] * v[q][i][1] + v[q][i][2] * v[q][i][2] + v[q][i][3] * v[q][i][3];
            ss[q] = rsqrtf(wave_sum(ss[q]) * (1.0f / D) + EPS); }
#pragma unroll
        for (int i = 0; i < 8; ++i) {
            const f32x4 w = ((const f32x4*)nw)[lane + i * 64];
#pragma unroll
            for (int q = 0; q < 4; ++q) {
                if (rb + q * (int)gridDim.x * 8 < T) {
                    u32x2 o; o.x = cvt_pk_bf16(v[q][i][0] * ss[q] * w[0], v[q][i][1] * ss[q] * w[1]); o.y = cvt_pk_bf16(v[q][i][2] * ss[q] * w[2], v[q][i][3] * ss[q] * w[3]);
                    ((u32x2*)(U + (size_t)rr[q] * D))[lane + i * 64] = o; }
            }
        }
    }
    transpose_tiles(a.in[I_WIN], (bf16_t*)(a.ws + WS_WINT), 2048, DIN, 116, 32 * 116, (float*)lds, blockIdx.x, gridDim.x);
}

constexpr int GS_HG = 16384, GS_GL = 32768;
__device__ __forceinline__ size_t gstate_off(int item) { return item < 128 ? (size_t)item * GS_HG : (size_t)128 * GS_HG + (size_t)(item - 128) * GS_GL; }

__device__ __forceinline__ void load_v128(u32x4 (&v)[2], const bf16_t* vsrc, const int tid) {
#pragma unroll
    for (int i = 0; i < 2; ++i) { const int idx = tid + i * 512, t = (idx >> 2) & 63, ch = (idx & 3) + 4 * (idx >> 8);
        v[i] = *(const u32x4*)(vsrc + (size_t)t * PS + ch * 8); }
}
__device__ __forceinline__ void store_vT128(bf16_t* vT, const u32x4 (&v)[2], const int tid) {
#pragma unroll
    for (int i = 0; i < 2; ++i) { const int idx = tid + i * 512, t = (idx >> 2) & 63, ch = (idx & 3) + 4 * (idx >> 8);
        bf16_t* d = vT + ((ch >> 2) * 32 + (ch & 3) * 4) * 72 + t;
        d[0 * 72] = (bf16_t)(v[i].x & 0xffffu); d[1 * 72] = (bf16_t)(v[i].x >> 16); d[2 * 72] = (bf16_t)(v[i].y & 0xffffu); d[3 * 72] = (bf16_t)(v[i].y >> 16);
        d[16 * 72] = (bf16_t)(v[i].z & 0xffffu); d[17 * 72] = (bf16_t)(v[i].z >> 16); d[18 * 72] = (bf16_t)(v[i].w & 0xffffu); d[19 * 72] = (bf16_t)(v[i].w >> 16); }
}
#define LDS_BARRIER() do { asm volatile("s_waitcnt lgkmcnt(0)" ::: "memory"); __builtin_amdgcn_s_barrier(); asm volatile("" ::: "memory"); } while (0)
template <bool OUT>
__device__ __forceinline__ void recur_pass(const Args& a, unsigned char* lds) {
    int tid = threadIdx.x; asm volatile("" : "+v"(tid));
    const int wid = __builtin_amdgcn_readfirstlane(tid >> 6), seg = __builtin_amdgcn_readfirstlane(tid >> 7);
    bf16_t* qs = (bf16_t*)lds;
    bf16_t* ks = (bf16_t*)(lds + 17408);
    bf16_t* khT = (bf16_t*)(lds + 34816);
    bf16_t* vT = (bf16_t*)(lds + 53248);
    bf16_t* sT = (bf16_t*)(lds + 71680);
    bf16_t* as = (bf16_t*)(lds + 106496);
    float* tot = (float*)(lds + 115712);
    float* decs = (float*)(lds + 117760);
    float* ssb = (float*)(lds + 118272);
    float* w2s = (float*)(lds + 118784);
    float* gls = (float*)(lds + 126976);
    float* nws = (float*)(lds + 131072);
    bf16_t* proj = (bf16_t*)(a.ws + WS_PROJ);
    const float* hg = (const float*)(a.ws + WS_HG);
    const float* glr = (const float*)(a.ws + WS_GLR);
    float* decg = (float*)(a.ws + WS_DEC);
    float* gst = a.out;
    bf16_t* ycat = (bf16_t*)(a.ws + WS_U);
    const int dkb = (wid & 3) * 32, nt0 = (wid >> 2) * 4;
    const int tb = wid & 3, ch = wid >> 2;
    for (int item = blockIdx.x; item < 256; item += gridDim.x) {
        const bool gla = item >= 128;
        int ti_ = tid; asm volatile("" : "+v"(ti_));
        const int c0_ = ti_ & 127, fr0_ = ti_ & 15, fq0_ = (ti_ & 63) >> 4;
        const int h = gla ? (item - 128) >> 5 : item >> 4, grp = gla ? (item - 128) & 31 : item & 15;
        const int G = gla ? 4 : 8, ntile = gla ? 2 : 1, chunk0 = grp * G;
        const int qoff = gla ? 4096 + h * 128 : h * 128;
        const int voff = gla ? 5120 + h * 256 : 2048 + h * 128;
        const int zoff = gla ? 6144 + h * 256 : 3072 + h * 128;
        const int yoff = gla ? 1024 + h * 256 : h * 128;
        const int dvtot = gla ? 256 : 128;
        const float* nw = gla ? a.in[I_GNW] + h * 256 : a.in[I_HNW] + h * 128;
        float* gs_item = gst + gstate_off(item);
        f32x4 S[2][2][4];
#pragma unroll
        for (int t = 0; t < 2; ++t)
#pragma unroll
            for (int n = 0; n < 2; ++n)
#pragma unroll
                for (int nt = 0; nt < 4; ++nt) {
                    S[t][n][nt] = (f32x4){0.f, 0.f, 0.f, 0.f};
                    if (OUT && t < ntile) S[t][n][nt] = *(const f32x4*)(gs_item + (size_t)(t * 128 + (nt0 + nt) * 16 + fr0_) * 128 + dkb + 8 * fq0_ + 4 * n);
                }
        float dprod = 1.0f;
        u32x4 qreg[2], kreg[2], vreg[2][2], zreg[2][2]; f32x4 glreg = (f32x4){0.f, 0.f, 0.f, 0.f};
        float g[16];
#define RP_LOAD_QK(T0) do { \
            if (OUT) { _Pragma("unroll") for (int i = 0; i < 2; ++i) { const int idx = tl_ + i * 512, row = idx >> 4, c8 = (idx & 15) * 8; qreg[i] = *(const u32x4*)(proj + (size_t)((T0) + row) * PS + qoff + c8); } } \
            if (gla) { _Pragma("unroll") for (int i = 0; i < 2; ++i) { const int idx = tl_ + i * 512, row = idx >> 4, c8 = (idx & 15) * 8; kreg[i] = *(const u32x4*)(proj + (size_t)((T0) + row) * PS + qoff + 512 + c8); } } } while (0)
#define RP_LOAD_G(T0) do { if (gla) { if (tl_ < 256) glreg = *(const f32x4*)(glr + (size_t)((T0) + (tl_ >> 2)) * 16 + (tl_ & 3) * 4); } else { _Pragma("unroll") for (int i = 0; i < 16; ++i) g[i] = hg[(size_t)((T0) + seg * 16 + i) * 1024 + h * 128 + (tl_ & 127)]; } } while (0)
#define RP_LOAD_V(T0) do { _Pragma("unroll") for (int t = 0; t < 2; ++t) if (t < ntile) load_v128(vreg[t], proj + (size_t)(T0) * PS + voff + t * 128, tl_); } while (0)
#define RP_LOAD_Z(T0) do { if (OUT) { _Pragma("unroll") for (int t = 0; t < 2; ++t) _Pragma("unroll") for (int p = 0; p < 2; ++p) if (t < ntile) \
            zreg[t][p] = *(const u32x4*)(proj + (size_t)((T0) + tb * 16 + (tl_ & 15)) * PS + zoff + t * 128 + ch * 64 + p * 32 + ((tl_ & 63) >> 4) * 8); } } while (0)
        { int tl_ = tid; asm volatile("" : "+v"(tl_)); const int T0 = chunk0 * 64; RP_LOAD_QK(T0); RP_LOAD_G(T0); RP_LOAD_V(T0); }
        float gbias = 0.f;
        if (OUT && ti_ < dvtot) nws[ti_] = nw[ti_];
        if (gla) {
            const float* w2 = a.in[I_GW2];
#pragma unroll
            for (int r = 0; r < 4; ++r) { const int rr = seg * 4 + r; w2s[rr * 128 + c0_] = w2[rr * 512 + h * 128 + c0_]; }
            gbias = a.in[I_GGB][h * 128 + c0_];
        }
        LDS_BARRIER();
        for (int ci = 0; ci < G; ++ci) {
            const int t0 = (chunk0 + ci) * 64, t0n = t0 + 64; const bool more = ci + 1 < G;
            int tl_ = tid; asm volatile("" : "+v"(tl_));
            const int c = tl_ & 127, fr = tl_ & 15, fq = (tl_ & 63) >> 4, prow = 8 * (fr >> 2) + (fr & 3);
            float b[16];
            if (OUT) {
#pragma unroll
                for (int i = 0; i < 2; ++i) { const int idx = tl_ + i * 512, row = idx >> 4, c8 = (idx & 15) * 8; *(u32x4*)(qs + row * 136 + c8) = qreg[i]; }
            }
            if (gla) {
#pragma unroll
                for (int i = 0; i < 2; ++i) { const int idx = tl_ + i * 512, row = idx >> 4, c8 = (idx & 15) * 8; *(u32x4*)(ks + row * 136 + c8) = kreg[i]; }
                if (tl_ < 256) *(f32x4*)(gls + (tl_ >> 2) * 16 + (tl_ & 3) * 4) = glreg;
            }
            if (gla) LDS_BARRIER();
            if (gla && !OUT) {
                float* gt = (float*)sT;
                const int gtb = wid & 3, gch = wid >> 2;
#pragma unroll
                for (int ct = 0; ct < 4; ++ct) {
                    const int col0 = gch * 64 + ct * 16;
                    f32x4 acc = (f32x4){0.f, 0.f, 0.f, 0.f};
#pragma unroll
                    for (int kk = 0; kk < 4; ++kk)
                        acc = __builtin_amdgcn_mfma_f32_16x16x4f32(gls[(gtb * 16 + fr) * 16 + kk * 4 + fq], w2s[(kk * 4 + fq) * 128 + col0 + fr], acc, 0, 0, 0);
#pragma unroll
                    for (int e = 0; e < 4; ++e) gt[(gtb * 16 + 4 * fq + e) * 136 + col0 + fr] = acc[e];
                }
                LDS_BARRIER();
#pragma unroll
                for (int i = 0; i < 16; ++i) {
                    const float sacc = gt[(seg * 16 + i) * 136 + c] + gbias;
                    g[i] = (fminf(sacc, 0.f) - __logf(1.0f + __expf(-fabsf(sacc)))) * (1.0f / 16.0f);
                }
            } else if (gla) {
                float wv[16];
#pragma unroll
                for (int r = 0; r < 16; ++r) wv[r] = w2s[r * 128 + c];
#pragma unroll
                for (int i = 0; i < 16; ++i) {
                    const float* gl = gls + (seg * 16 + i) * 16;
                    float sacc = gbias;
#pragma unroll
                    for (int r4 = 0; r4 < 4; ++r4) { const f32x4 gv = *(const f32x4*)(gl + r4 * 4);
                        sacc += gv[0] * wv[r4 * 4] + gv[1] * wv[r4 * 4 + 1] + gv[2] * wv[r4 * 4 + 2] + gv[3] * wv[r4 * 4 + 3]; }
                    g[i] = (fminf(sacc, 0.f) - __logf(1.0f + __expf(-fabsf(sacc)))) * (1.0f / 16.0f);
                }
            }
            b[0] = g[0];
            if (gla) {
#pragma unroll
                for (int i = 1; i < 16; ++i) b[i] = b[i - 1] + g[i];
            } else {
#pragma unroll
                for (int i = 1; i < 16; ++i) b[i] = b[i - 1] * g[i];
            }
            tot[seg * 128 + c] = b[15];
            LDS_BARRIER();
            float dlast;
            float kv[16];
            if (gla) {
                float pre = 0.f, blast = 0.f;
#pragma unroll
                for (int s4 = 0; s4 < 4; ++s4) { const float tv = tot[s4 * 128 + c]; if (s4 < seg) pre += tv; blast += tv; }
                dlast = __expf(blast);
#pragma unroll
                for (int i = 0; i < 16; ++i) { kv[i] = bf2f(ks[(seg * 16 + i) * 136 + c]); b[i] = __expf(b[i] + pre); }
            } else {
                float pre = 1.f, plast = 1.f;
#pragma unroll
                for (int s4 = 0; s4 < 4; ++s4) { const float tv = tot[s4 * 128 + c]; if (s4 < seg) pre *= tv; plast *= tv; }
                dlast = plast;
#pragma unroll
                for (int i = 0; i < 16; ++i) { kv[i] = 1.0f - g[i]; b[i] *= pre; }
            }
            {
                unsigned kh[8];
#pragma unroll
                for (int i = 0; i < 16; i += 2) {
                    float khv[2];
#pragma unroll
                    for (int e = 0; e < 2; ++e) {
                        const int ii = i + e, tl = seg * 16 + ii;
                        const float eb = b[ii];
                        const float k = kv[ii];
                        const float kinv = k * __builtin_amdgcn_rcpf(eb);
                        if (OUT) {
                            const float q = bf2f(qs[tl * 136 + c]);
                            qs[tl * 136 + c] = f2bf(q * eb);
                            ks[tl * 136 + c] = f2bf(kinv);
                        }
                        khv[e] = kinv * dlast;
                    }
                    kh[i >> 1] = cvt_pk_bf16(khv[0], khv[1]);
                }
                const int cs = (c & ~31) + 16 * ((c >> 2) & 1) + 4 * ((c >> 3) & 3) + (c & 3);
                *(u32x4*)(khT + cs * 72 + seg * 16) = (u32x4){kh[0], kh[1], kh[2], kh[3]};
                *(u32x4*)(khT + cs * 72 + seg * 16 + 8) = (u32x4){kh[4], kh[5], kh[6], kh[7]};
            }
            const float dch = dlast;
            if (seg == 0) decs[c] = dch;
            dprod *= dch;
            LDS_BARRIER();
            RP_LOAD_Z(t0);
            if (OUT) {
#pragma unroll
                for (int rep = 0; rep < 2; ++rep) {
                    const int idx = wid + rep * 8, ti = idx >> 2, tj = idx & 3;
                    f32x4 acc = (f32x4){0.f, 0.f, 0.f, 0.f};
                    if (tj <= ti) {
#pragma unroll
                        for (int kk = 0; kk < 4; ++kk) {
                            const bf16x8 af = *(const bf16x8*)(ks + (tj * 16 + fr) * 136 + kk * 32 + fq * 8);
                            const bf16x8 bf = *(const bf16x8*)(qs + (ti * 16 + fr) * 136 + kk * 32 + fq * 8);
                            acc = __builtin_amdgcn_mfma_f32_16x16x32_bf16(af, bf, acc, 0, 0, 0);
                        }
                    }
                    const int i_ = ti * 16 + fr, j0 = tj * 16 + fq * 4;
                    u32x2 o;
                    o.x = cvt_pk_bf16(j0 + 0 <= i_ ? acc[0] : 0.f, j0 + 1 <= i_ ? acc[1] : 0.f);
                    o.y = cvt_pk_bf16(j0 + 2 <= i_ ? acc[2] : 0.f, j0 + 3 <= i_ ? acc[3] : 0.f);
                    *(u32x2*)(as + i_ * 72 + j0) = o;
                }
            }
            float dsc[2][4];
#pragma unroll
            for (int n = 0; n < 2; ++n)
#pragma unroll
                for (int e = 0; e < 4; ++e) dsc[n][e] = decs[dkb + 8 * fq + 4 * n + e];
            bf16x8 af[2][2];
#pragma unroll
            for (int n = 0; n < 2; ++n)
#pragma unroll
                for (int kk = 0; kk < 2; ++kk) af[n][kk] = *(const bf16x8*)(khT + (dkb + n * 16 + fr) * 72 + kk * 32 + fq * 8);
            f32x4 ao[2][4];
            float ss = 0.f;
#pragma unroll
            for (int t = 0; t < 2; ++t) {
#pragma unroll
                for (int x = 0; x < 4; ++x) ao[t][x] = (f32x4){0.f, 0.f, 0.f, 0.f};
                if (t < ntile) {
                    store_vT128(vT, vreg[t], tl_);
                    if (OUT) {
#pragma unroll
                        for (int nt = 0; nt < 4; ++nt) {
                            u32x4 o; o.x = cvt_pk_bf16(S[t][0][nt][0], S[t][0][nt][1]); o.y = cvt_pk_bf16(S[t][0][nt][2], S[t][0][nt][3]);
                            o.z = cvt_pk_bf16(S[t][1][nt][0], S[t][1][nt][1]); o.w = cvt_pk_bf16(S[t][1][nt][2], S[t][1][nt][3]);
                            *(u32x4*)(sT + ((nt0 + nt) * 16 + fr) * 136 + dkb + 8 * fq) = o;
                        }
                    }
                    LDS_BARRIER();
                    if (OUT) {
                        bf16x8 ba[2], bq[4];
#pragma unroll
                        for (int kk = 0; kk < 2; ++kk) ba[kk] = *(const bf16x8*)(as + (tb * 16 + fr) * 72 + kk * 32 + fq * 8);
#pragma unroll
                        for (int kk = 0; kk < 4; ++kk) bq[kk] = *(const bf16x8*)(qs + (tb * 16 + fr) * 136 + kk * 32 + fq * 8);
#pragma unroll
                        for (int p = 0; p < 2; ++p)
#pragma unroll
                            for (int n = 0; n < 2; ++n) {
                                const int dvr = ch * 64 + p * 32 + n * 16 + fr;
                                f32x4 acc = (f32x4){0.f, 0.f, 0.f, 0.f};
#pragma unroll
                                for (int kk = 0; kk < 2; ++kk) acc = __builtin_amdgcn_mfma_f32_16x16x32_bf16(*(const bf16x8*)(vT + dvr * 72 + kk * 32 + fq * 8), ba[kk], acc, 0, 0, 0);
#pragma unroll
                                for (int kk = 0; kk < 4; ++kk) acc = __builtin_amdgcn_mfma_f32_16x16x32_bf16(*(const bf16x8*)(sT + dvr * 136 + kk * 32 + fq * 8), bq[kk], acc, 0, 0, 0);
                                ao[t][p * 2 + n] = acc;
                                ss += acc[0] * acc[0] + acc[1] * acc[1] + acc[2] * acc[2] + acc[3] * acc[3];
                                __builtin_amdgcn_sched_barrier(0);
                            }
                    }
#pragma unroll
                    for (int nt = 0; nt < 4; ++nt) {
                        const bf16x8 b0 = *(const bf16x8*)(vT + ((nt0 + nt) * 16 + fr) * 72 + fq * 8), b1 = *(const bf16x8*)(vT + ((nt0 + nt) * 16 + fr) * 72 + 32 + fq * 8);
#pragma unroll
                        for (int n = 0; n < 2; ++n) {
                            f32x4 sv = S[t][n][nt];
#pragma unroll
                            for (int e = 0; e < 4; ++e) sv[e] *= dsc[n][e];
                            sv = __builtin_amdgcn_mfma_f32_16x16x32_bf16(af[n][0], b0, sv, 0, 0, 0);
                            sv = __builtin_amdgcn_mfma_f32_16x16x32_bf16(af[n][1], b1, sv, 0, 0, 0);
                            S[t][n][nt] = sv;
                        }
                        __builtin_amdgcn_sched_barrier(0);
                    }
                    if (t + 1 < ntile) LDS_BARRIER();
                }
            }
            if (more) { RP_LOAD_QK(t0n); RP_LOAD_G(t0n); RP_LOAD_V(t0n); }
            if (OUT) {
                ss += __shfl_xor(ss, 16); ss += __shfl_xor(ss, 32);
                if (fq == 0) ssb[ch * 64 + tb * 16 + fr] = ss;
                LDS_BARRIER();
                const float rstd = rsqrtf((ssb[tb * 16 + fr] + ssb[64 + tb * 16 + fr]) / (float)dvtot + EPS);
                const size_t trow = (size_t)(t0 + tb * 16 + fr);
#pragma unroll
                for (int t = 0; t < 2; ++t)
#pragma unroll
                    for (int p = 0; p < 2; ++p) {
                        if (t < ntile) {
                            const int d0 = t * 128 + ch * 64 + p * 32 + fq * 8;
                            const f32x4 w0 = *(const f32x4*)(nws + d0), w1 = *(const f32x4*)(nws + d0 + 4);
                            const u32x4 z = zreg[t][p];
                            const f32x4 x0 = ao[t][p * 2], x1 = ao[t][p * 2 + 1];
                            u32x4 o;
                            o.x = cvt_pk_bf16(x0[0] * rstd * w0[0] * bflo(z.x), x0[1] * rstd * w0[1] * bfhi(z.x));
                            o.y = cvt_pk_bf16(x0[2] * rstd * w0[2] * bflo(z.y), x0[3] * rstd * w0[3] * bfhi(z.y));
                            o.z = cvt_pk_bf16(x1[0] * rstd * w1[0] * bflo(z.z), x1[1] * rstd * w1[1] * bfhi(z.z));
                            o.w = cvt_pk_bf16(x1[2] * rstd * w1[2] * bflo(z.w), x1[3] * rstd * w1[3] * bfhi(z.w));
                            *(u32x4*)(ycat + trow * D + yoff + d0) = o;
                        }
                    }
            }
        }
#undef RP_LOAD_QK
#undef RP_LOAD_G
#undef RP_LOAD_V
#undef RP_LOAD_Z
        if (!OUT) {
            int te_ = tid; asm volatile("" : "+v"(te_));
            const int c0_ = te_ & 127, fr0_ = te_ & 15, fq0_ = (te_ & 63) >> 4;
#pragma unroll
            for (int t = 0; t < 2; ++t)
#pragma unroll
                for (int n = 0; n < 2; ++n)
#pragma unroll
                    for (int nt = 0; nt < 4; ++nt)
                        if (t < ntile) *(f32x4*)(gs_item + (size_t)(t * 128 + (nt0 + nt) * 16 + fr0_) * 128 + dkb + 8 * fq0_ + 4 * n) = S[t][n][nt];
            if (seg == 0) decg[(size_t)item * 128 + c0_] = dprod;
        }
    }
}

__device__ __forceinline__ void recur_scan(const Args& a) {
    float* gst = a.out; const float* decg = (const float*)(a.ws + WS_DEC);
    for (int e2 = blockIdx.x * 512 + threadIdx.x; e2 < 131072; e2 += gridDim.x * 512) {
        const bool gla = e2 >= 65536;
        const int e = (gla ? e2 - 65536 : e2) * 2;
        const int h = gla ? e >> 15 : e >> 14, idx = gla ? e & 32767 : e & 16383, dk = idx & 127;
        const int ng = gla ? 32 : 16, item0 = gla ? 128 + h * 32 : h * 16;
        const size_t gsz = gla ? GS_GL : GS_HG;
        float* p = gst + gstate_off(item0) + idx;
        const float* dp = decg + (size_t)item0 * 128 + dk;
        float s0 = 0.f, s1 = 0.f;
        for (int g0 = 0; g0 < ng; g0 += 8) {
            f32x2 d[8], dc[8];
#pragma unroll
            for (int i = 0; i < 8; ++i) { d[i] = *(const f32x2*)(p + (size_t)(g0 + i) * gsz); dc[i] = *(const f32x2*)(dp + (size_t)(g0 + i) * 128); }
#pragma unroll
            for (int i = 0; i < 8; ++i) {
                *(f32x2*)(p + (size_t)(g0 + i) * gsz) = (f32x2){s0, s1};
                s0 = dc[i][0] * s0 + d[i][0]; s1 = dc[i][1] * s1 + d[i][1];
            }
        }
    }
}

__device__ __forceinline__ void phase_final(const Args& a) {
    const int tid = threadIdx.x, wid = tid >> 6, lane = tid & 63;
    const float* h2ss = (const float*)(a.ws + WS_H2SS); const float* fw = a.in[I_FNW];
    for (int r = blockIdx.x * 8 + wid; r < T; r += gridDim.x * 8) {
        float s = lane < 32 ? h2ss[(size_t)r * 32 + lane] : 0.f;
        s = wave_sum(s);
        const float rstd = rsqrtf(s * (1.0f / D) + EPS);
        f32x4* o = (f32x4*)(a.out + (size_t)r * D);
#pragma unroll
        for (int i = 0; i < 8; ++i) { const f32x4 w = ((const f32x4*)fw)[lane + i * 64]; f32x4 v = o[lane + i * 64]; v = v * rstd * w; o[lane + i * 64] = v; }
    }
}

#define XB_TMO      128
#define XB_XCNT(j)  (256  + 64 * (j))
#define XB_XSUB(j)  (1280 + 64 * (j))
#define XB_XGEN(j)  (2304 + 64 * (j))
#define XB_TOP      3328
#define XB_TOPGEN   3392
#define XCD_BAR_WORDS 3456
#define XB_SPIN_CAP (1u << 18)

__device__ __forceinline__ unsigned xb_ld(unsigned* p)              { return __hip_atomic_load(p, __ATOMIC_RELAXED, __HIP_MEMORY_SCOPE_AGENT); }
__device__ __forceinline__ unsigned xb_add(unsigned* p, unsigned v) { return __hip_atomic_fetch_add(p, v, __ATOMIC_RELAXED, __HIP_MEMORY_SCOPE_AGENT); }
__device__ __forceinline__ unsigned xb_xcc_id() { return (unsigned)__builtin_amdgcn_s_getreg((3 << 11) | 20) & 0xFu; }
#define XB_SPIN(cond, bar) do { unsigned _sp = 0; while (cond) { __builtin_amdgcn_s_sleep(1); \
    if ((++_sp & 255u) == 0u) { if (xb_ld(&(bar)[XB_TMO])) break; if (_sp > XB_SPIN_CAP) { atomicAdd(&(bar)[XB_TMO], 1u); break; } } } } while (0)

struct XcdBarrier {
    unsigned* bar; unsigned x;
    volatile LAS unsigned* st;
};

__device__ __forceinline__ XcdBarrier xcd_barrier_post(unsigned* bar, volatile LAS unsigned* st) {
    XcdBarrier b; b.bar = bar; b.x = xb_xcc_id(); b.st = st;
    if (threadIdx.x == 0) (void)xb_add(&bar[XB_XCNT(b.x)], 1u);
    return b;
}
__device__ __forceinline__ void xcd_barrier_complete(unsigned* bar, unsigned x, unsigned& nloc, unsigned& nx) {
    const unsigned G = gridDim.x * gridDim.y * gridDim.z;
    unsigned sum, cnt, mine, sp = 0u;
    for (;;) {
        sum = 0u; cnt = 0u; mine = 0u;
#pragma unroll
        for (unsigned j = 0; j < 16; ++j) { const unsigned c = xb_ld(&bar[XB_XCNT(j)]); sum += c; cnt += (c > 0u) ? 1u : 0u; mine = (j == x) ? c : mine; }
        if (sum == G) break;
        __builtin_amdgcn_s_sleep(1);
        if ((++sp & 255u) == 0u) { if (xb_ld(&bar[XB_TMO])) break; if (sp > XB_SPIN_CAP) { atomicAdd(&bar[XB_TMO], 1u); break; } }
    }
    nloc = mine > 0u ? mine : 1u; nx = cnt > 0u ? cnt : 1u;
}

__device__ __forceinline__ void xcd_barrier(const XcdBarrier& b) {
    asm volatile("s_waitcnt vmcnt(0)" ::: "memory");
    __syncthreads();
    if (threadIdx.x == 0) {
        unsigned* bar = b.bar;
        __builtin_amdgcn_s_waitcnt(0);
        unsigned nloc = b.st[0], nx = b.st[1];
        if (nloc == 0u) { xcd_barrier_complete(bar, b.x, nloc, nx); b.st[0] = nloc; b.st[1] = nx; }
        const unsigned old = xb_add(&bar[XB_XSUB(b.x)], 1u);
        const unsigned gen = old / nloc;
        if (old + 1u == (gen + 1u) * nloc) {
            __builtin_amdgcn_fence(__ATOMIC_RELEASE, "agent");
            asm volatile("s_waitcnt vmcnt(0)" ::: "memory");
            const unsigned og = xb_add(&bar[XB_TOP], 1u);
            const unsigned tg = og / nx;
            if (og + 1u == (tg + 1u) * nx) xb_add(&bar[XB_TOPGEN], 1u);
            else XB_SPIN(xb_ld(&bar[XB_TOPGEN]) == tg, bar);
            __builtin_amdgcn_fence(__ATOMIC_ACQUIRE, "agent");
            xb_add(&bar[XB_XGEN(b.x)], 1u);
            asm volatile("s_waitcnt vmcnt(0)" ::: "memory");
        } else {
            XB_SPIN(xb_ld(&bar[XB_XGEN(b.x)]) == gen, bar);
            __builtin_amdgcn_fence(__ATOMIC_ACQUIRE, "agent");
            asm volatile("s_waitcnt vmcnt(0)" ::: "memory");
        }
    }
    __syncthreads();
}


struct Epi4F {
    static constexpr bool PERM = true, AFTER_DRAIN = true;
    const bf16_t* e; const float* gb; const float* pnw; const bf16_t* hbf; float* out; const float* fnw; unsigned* xs; unsigned* cnt; unsigned* bar;
    __device__ __forceinline__ void operator()(const f32x4 (&)[2][2][4][2], const Unit&, int, int, int, int) const {}
    __device__ __forceinline__ void fused(f32x4 (&acc)[2][2][4][2], const Unit& u, int wr, int wc, int fr, int fq, LAS unsigned char* lds) const {
        asm volatile("" : "+v"(fr), "+v"(fq));
        const int row0 = u.pm * BM + wr * 64 + fr, col0 = u.pn * BM + wc * 32 + 8 * fq;
        const LAS float* rs = (const LAS float*)(lds + STAGE_BYTES) + (wr * 64 + fr) * 2;
        LAS float* part = (LAS float*)lds;
        LAS float* rstd2 = (LAS float*)(lds + 4096);
#pragma unroll
        for (int ai = 0; ai < 2; ++ai)
#pragma unroll
            for (int m = 0; m < 4; ++m) {
                const size_t r = (size_t)(row0 + ai * HALF + m * 16);
                const float rhh = rs[(ai * HALF + m * 16) * 2], ree = rs[(ai * HALF + m * 16) * 2 + 1];
                float s = 0.f;
#pragma unroll
                for (int bj = 0; bj < 2; ++bj) {
                    const int c = col0 + bj * HALF;
                    const size_t o = r * D + c;
                    const f32x4 b0 = *(const f32x4*)(gb + c), b1 = *(const f32x4*)(gb + c + 4), w0 = *(const f32x4*)(pnw + c), w1 = *(const f32x4*)(pnw + c + 4);
                    const u32x4 ev = *(const u32x4*)(e + o);
                    const u32x4 hv = *(const u32x4*)(hbf + o);
                    f32x4 h0, h1;
                    h0[0] = bflo(hv.x); h0[1] = bfhi(hv.x); h0[2] = bflo(hv.y); h0[3] = bfhi(hv.y); h1[0] = bflo(hv.z); h1[1] = bfhi(hv.z); h1[2] = bflo(hv.w); h1[3] = bfhi(hv.w);
                    f32x4 e0, e1;
                    e0[0] = bflo(ev.x); e0[1] = bfhi(ev.x); e0[2] = bflo(ev.y); e0[3] = bfhi(ev.y);
                    e1[0] = bflo(ev.z); e1[1] = bfhi(ev.z); e1[2] = bflo(ev.w); e1[3] = bfhi(ev.w);
#pragma unroll
                    for (int j = 0; j < 4; ++j) {
                        const float g0 = sigmoidf_(acc[ai][bj][m][0][j] * rhh + b0[j]), g1 = sigmoidf_(acc[ai][bj][m][1][j] * rhh + b1[j]);
                        h0[j] += g0 * (e0[j] * ree * w0[j]); h1[j] += g1 * (e1[j] * ree * w1[j]);
                        s += h0[j] * h0[j] + h1[j] * h1[j];
                    }
                    acc[ai][bj][m][0] = h0; acc[ai][bj][m][1] = h1;
                }
                s += __shfl_xor(s, 16); s += __shfl_xor(s, 32);
                if (fq == 0) part[(wr * 64 + fr + ai * HALF + m * 16) * 4 + wc] = s;
            }
        __syncthreads();
        const int tid = threadIdx.x;
        if (tid < 256) {
            const float sum = (part[tid * 4 + 0] + part[tid * 4 + 1]) + (part[tid * 4 + 2] + part[tid * 4 + 3]);
            __hip_atomic_store(xs + ((size_t)(u.pm * 8 + u.pn) * 256 + tid), __float_as_uint(sum), __ATOMIC_RELAXED, __HIP_MEMORY_SCOPE_AGENT);
        }
        asm volatile("s_waitcnt vmcnt(0)" ::: "memory");
        __syncthreads();
        if (tid == 0) {
            (void)xb_add(cnt + u.pm * 64, 1u);
            XB_SPIN(xb_ld(cnt + u.pm * 64) < 8u, bar);
        }
        __syncthreads();
        if (tid < 256) {
            float sum = 0.f;
#pragma unroll
            for (int k = 0; k < 8; ++k) sum += __uint_as_float(__hip_atomic_load(xs + ((size_t)(u.pm * 8 + k) * 256 + tid), __ATOMIC_RELAXED, __HIP_MEMORY_SCOPE_AGENT));
            rstd2[tid] = rsqrtf(sum * (1.0f / D) + EPS);
        }
        __syncthreads();
#pragma unroll
        for (int ai = 0; ai < 2; ++ai)
#pragma unroll
            for (int m = 0; m < 4; ++m) {
                const size_t r = (size_t)(row0 + ai * HALF + m * 16);
                const float rr = rstd2[wr * 64 + fr + ai * HALF + m * 16];
#pragma unroll
                for (int bj = 0; bj < 2; ++bj) {
                    const int c = col0 + bj * HALF;
                    const f32x4 f0 = *(const f32x4*)(fnw + c), f1 = *(const f32x4*)(fnw + c + 4);
                    *(f32x4*)(out + r * D + c) = acc[ai][bj][m][0] * rr * f0; *(f32x4*)(out + r * D + c + 4) = acc[ai][bj][m][1] * rr * f1;
                }
                __builtin_amdgcn_sched_barrier(0);
            }
    }
};

constexpr int N_PHASES = 8;
#ifndef PHASE_MASK
#define PHASE_MASK 0xff
#endif
#define PH_ON(p) ((PHASE_MASK >> (p)) & 1)
__global__ void __launch_bounds__(512, 2) fwd_kernel(Args a) {
    extern __shared__ __attribute__((aligned(16))) unsigned char lds[];
    cg::grid_group grid = cg::this_grid();
    if (a.ph_lo < 0) grid.sync();
    if (threadIdx.x == 0) { volatile LAS unsigned* st = (volatile LAS unsigned*)(((LAS unsigned char*)lds) + LDS_XB); st[0] = 0u; st[1] = 0u; }
    __syncthreads();
    const XcdBarrier xb = xcd_barrier_post((unsigned*)(a.ws + WS_BAR), (volatile LAS unsigned*)(((LAS unsigned char*)lds) + LDS_XB));
    const bool fuse_final = (gridDim.x == 256) && (a.ph_hi - a.ph_lo == N_PHASES);
#define RUN(p) (PH_ON(p) && a.ph_lo <= (p) && (p) < a.ph_hi)
#define SEAM(p) do { if (a.ph_lo < (p)) xcd_barrier(xb); } while (0)
    {
        if (RUN(0)) {
            phase_prep(a, lds);
        }
        if (RUN(1)) { SEAM(1);
            Gemm g{(const bf16_t*)(a.ws + WS_U), (const bf16_t*)(a.ws + WS_WINT), T, NPAD, D};
            StaticOrder S; S.init(T, NPAD, (int)gridDim.x, (int)blockIdx.x, 1);
            Epi1 E{(bf16_t*)(a.ws + WS_PROJ), (float*)(a.ws + WS_HG), (float*)(a.ws + WS_GLR), a.in[I_HLB]};
            gemm_phase(((LAS unsigned char*)lds), g, S, E);
            {
                const int G = (int)gridDim.x, R = (S.nwg + G - 1) / G; int c0 = S.nwg - (R - 1) * G; if (c0 >= G) c0 = 0;
                if ((int)blockIdx.x >= c0) {
                    transpose_tiles(a.in[I_WOUT], (bf16_t*)(a.ws + WS_WOUTT), 2048, 2048, 32, 32 * 32, (float*)lds, (int)blockIdx.x - c0, G - c0);
                    transpose_tiles(a.in[I_PGW], (bf16_t*)(a.ws + WS_WGT), 2048, 2048, 32, 32 * 32, (float*)lds, (int)blockIdx.x - c0, G - c0, a.in[I_PGNW]);
                    transpose_tiles(a.in[I_PPROJ], (bf16_t*)(a.ws + WS_WPT), 256, 2048, 32, 4 * 32, (float*)lds, (int)blockIdx.x - c0, G - c0);
                    {
                        const f32x4* p4 = (const f32x4*)a.in[I_P]; u32x2* pb = (u32x2*)(a.ws + WS_PB);
                        for (int i = ((int)blockIdx.x - c0) * 512 + (int)threadIdx.x; i < T * 256 / 4; i += (G - c0) * 512) {
                            const f32x4 v = __builtin_nontemporal_load(p4 + i); u32x2 o; o.x = cvt_pk_bf16(v[0], v[1]); o.y = cvt_pk_bf16(v[2], v[3]); pb[i] = o;
                        }
                    }
                }
            }
        }
        if (RUN(2)) { SEAM(2);
            recur_pass<false>(a, lds);
        }
        if (RUN(3)) { SEAM(3);
            recur_scan(a);
        }
        if (RUN(4)) { SEAM(4);
            recur_pass<true>(a, lds);
        }
        if (RUN(5)) { SEAM(5);
            { Gemm g{(const bf16_t*)(a.ws + WS_U), (const bf16_t*)(a.ws + WS_WOUTT), T, D, D};
              StaticOrder S; S.init(T, D, (int)gridDim.x, (int)blockIdx.x);
              Epi2 E{a.in[I_X], (bf16_t*)(a.ws + WS_PROJ), (float*)(a.ws + WS_HSS)};
              gemm_phase(((LAS unsigned char*)lds), g, S, E); }
            { Gemm g{(const bf16_t*)(a.ws + WS_PB), (const bf16_t*)(a.ws + WS_WPT), T, D, 256};
              StaticOrder S; S.init(T, D, (int)gridDim.x, (int)blockIdx.x);
              Epi3 E{(bf16_t*)(a.ws + WS_HG), (float*)(a.ws + WS_ESS)};
              gemm_phase(((LAS unsigned char*)lds), g, S, E); }
        }
        if (RUN(6)) { SEAM(6);
            Gemm g{(const bf16_t*)(a.ws + WS_PROJ), (const bf16_t*)(a.ws + WS_WGT), T, D, D};
            StaticOrder S; S.init(T, D, (int)gridDim.x, (int)blockIdx.x);
            {
                LAS float* rsT = (LAS float*)(((LAS unsigned char*)lds) + STAGE_BYTES);
                const float* hss = (const float*)(a.ws + WS_HSS); const float* ess = (const float*)(a.ws + WS_ESS);
                for (int i = 0; i < 4; ++i) { Unit u; if (!S.next(i, u)) break;
                    const int row = threadIdx.x >> 1, which = threadIdx.x & 1;
                    const float* src = (which ? ess : hss) + (size_t)(u.pm * BM + row) * 32;
                    float sum = 0.f;
#pragma unroll
                    for (int k = 0; k < 8; ++k) { const f32x4 v = *(const f32x4*)(src + 4 * k); sum += (v[0] + v[1]) + (v[2] + v[3]); }
                    rsT[(i * 256 + row) * 2 + which] = rsqrtf(sum * (1.0f / D) + EPS);
                }
                __syncthreads();
            }
            if (fuse_final) {
                Epi4F E{(const bf16_t*)(a.ws + WS_HG), a.in[I_PGB], a.in[I_PNW], (const bf16_t*)(a.ws + WS_PROJ), a.out, a.in[I_FNW], (unsigned*)(a.ws + WS_XS), (unsigned*)(a.ws + WS_CNT), (unsigned*)(a.ws + WS_BAR)};
                gemm_phase(((LAS unsigned char*)lds), g, S, E);
            } else {
                Epi4 E{(const bf16_t*)(a.ws + WS_HG), a.in[I_PGB], a.in[I_PNW], (const bf16_t*)(a.ws + WS_PROJ), a.out, (float*)(a.ws + WS_H2SS), (const LAS float*)(((LAS unsigned char*)lds) + STAGE_BYTES), S};
                gemm_phase(((LAS unsigned char*)lds), g, S, E);
            }
        }
        if (RUN(7) && !fuse_final) { SEAM(7);
            phase_final(a);
        }
    }
}


extern "C" void kernel_launch(void* const* d_in, const int* in_sizes, int n_in, void* d_out, int out_size, void* d_ws, size_t ws_size, hipStream_t stream) {
    static int grid_blocks = 0;
    if (!grid_blocks) {
        int dev = 0, cus = 0, per_cu = 0;
        hipGetDevice(&dev);
        hipDeviceGetAttribute(&cus, hipDeviceAttributeMultiprocessorCount, dev);
        hipFuncSetAttribute((const void*)fwd_kernel, hipFuncAttributeMaxDynamicSharedMemorySize, LDS_BYTES);
        hipOccupancyMaxActiveBlocksPerMultiprocessor(&per_cu, fwd_kernel, 512, LDS_BYTES);
        if (per_cu < 1) { fprintf(stderr, "kernel_launch: occupancy query says %d blocks per CU\n", per_cu); per_cu = 1; }
        grid_blocks = cus * 1;
        if (n_in != 16 || ws_size < WS_END) fprintf(stderr, "kernel_launch: unexpected n_in %d / ws_size %zu (need %zu)\n", n_in, ws_size, (size_t)WS_END);
    }
    Args a{};
    for (int i = 0; i < 16; ++i) a.in[i] = (const float*)d_in[i];
    a.out = (float*)d_out; a.ws = (unsigned char*)d_ws;
#if MK_MULTI
    for (int ph = 0; ph < N_PHASES; ++ph) {
        a.ph_lo = ph; a.ph_hi = ph + 1;
        hipLaunchKernelGGL(fwd_kernel, dim3(grid_blocks), dim3(512), LDS_BYTES, stream, a);
    }
#else
    a.ph_lo = 0; a.ph_hi = N_PHASES;
    hipMemsetAsync((unsigned char*)d_ws + WS_BAR, 0, 16384 + 8192, stream);
    void* kargs[] = {&a};
    hipError_t e = hipLaunchCooperativeKernel((const void*)fwd_kernel, dim3(grid_blocks), dim3(512), kargs, LDS_BYTES, stream);
    if (e != hipSuccess) fprintf(stderr, "cooperative launch failed: %s (grid %d)\n", hipGetErrorString(e), grid_blocks);
#endif
}
```
